# Optimizing an MI355X kernel written in HIP

```python
import math
import jax, jax.numpy as jnp
from jax import lax
import numpy as np

D_MODEL = 1024
BATCH = 4
SEQ = 8192
DEPTH = 1
DEC_BATCH = 16
DEC_SEQ = 4096
PAST_LEN = 128

MIX_WIDTH = D_MODEL
HY_WIDTH = MIX_WIDTH // 2
ML_WIDTH = MIX_WIDTH - HY_WIDTH
ML_HEADS = 4
ML_HEAD_DIM = ML_WIDTH // ML_HEADS
ML_CHUNK = 64
HY_ORDER = 2
HY_EMB = 33
HY_BANDS = (HY_EMB - 1) // 2
HY_FILTER_HIDDEN = 64
HY_DECAY_TARGET = 1e-2
HY_FAST_DECAY_PCT = 0.3
HY_SLOW_DECAY_PCT = 1.5
HY_MAX_DECAY = math.log(HY_DECAY_TARGET) / HY_FAST_DECAY_PCT
HY_MIN_DECAY = math.log(HY_DECAY_TARGET) / HY_SLOW_DECAY_PCT
D_FF = 2816
EPS = 1e-6

OFF_Q = 3 * HY_WIDTH
OFF_K = OFF_Q + ML_WIDTH
OFF_V = OFF_K + ML_WIDTH
OFF_O = OFF_V + ML_WIDTH
OFF_G = OFF_O + ML_WIDTH
N_GATE = 4 * ML_HEADS
P_IN = OFF_G + N_GATE
CONV_CH = OFF_V

kernel_name = "hyena_mlstm_parallel_encoder"

F32 = jnp.float32


def rmsnorm(x, g):
    xf = x.astype(F32)
    y = xf * lax.rsqrt(jnp.mean(jnp.square(xf), axis=-1, keepdims=True) + EPS)
    return (y * g.astype(F32)).astype(x.dtype)


def dwconv3(x, w, b):
    xp = jnp.pad(x, ((0, 0), (1, 1), (0, 0)))
    return xp[:, :-2] * w[0] + xp[:, 1:-1] * w[1] + xp[:, 2:] * w[2] + b


def hyena_filter_spectrum(L, w1, b1, fr1, w2, b2, fr2, w3):
    t = jnp.linspace(0.0, 1.0, L, dtype=F32)[:, None]
    freqs = jnp.linspace(1e-4, HY_BANDS - 1, HY_BANDS, dtype=F32)
    ang = (2.0 * math.pi / L) * jnp.arange(L, dtype=F32)[:, None] * freqs[None, :]
    z = jnp.concatenate([t, jnp.cos(ang), -jnp.sin(ang)], axis=-1)
    h = jnp.sin(fr1.astype(F32) * (z @ w1.astype(F32) + b1.astype(F32)))
    h = jnp.sin(fr2.astype(F32) * (h @ w2.astype(F32) + b2.astype(F32)))
    h = (h @ w3.astype(F32)).reshape(L, 2, HY_ORDER, HY_WIDTH)
    deltas = jnp.abs(jnp.linspace(HY_MIN_DECAY, HY_MAX_DECAY, HY_WIDTH, dtype=F32))
    h = h * jnp.exp(-t * deltas)[:, None, None, :]
    kern = jnp.concatenate([h[:, 0], jnp.zeros((1, HY_ORDER, HY_WIDTH), F32), h[:0:-1, 1]], axis=0)
    kern = kern * lax.rsqrt(jnp.sum(jnp.square(kern), axis=0, keepdims=True))
    return jnp.fft.rfft(kern, axis=0)


def hyena_mix(x1, x2, v, kspec, bias):
    L = v.shape[1]
    bias = bias.astype(F32)

    def long_conv(z, ks, d):
        zf = jnp.fft.rfft(z, n=2 * L, axis=1)
        return jnp.fft.irfft(zf * ks[None], n=2 * L, axis=1)[:, :L] + d * z

    z = x1.astype(F32) * long_conv(v.astype(F32), kspec[:, 0], bias[0])
    return x2.astype(F32) * long_conv(z, kspec[:, 1], bias[1])


def mlstm_chunkwise(q, k, v, ig, fg):
    B, H, S, DH = q.shape
    NC = S // ML_CHUNK
    q = q.reshape(B, H, NC, ML_CHUNK, DH)
    k = k.reshape(B, H, NC, ML_CHUNK, DH)
    v = v.reshape(B, H, NC, ML_CHUNK, DH)
    ig = ig.reshape(B, H, NC, ML_CHUNK)
    b = jnp.cumsum(jax.nn.log_sigmoid(fg).reshape(B, H, NC, ML_CHUNK), axis=-1)
    b_last = b[..., -1]
    a = b_last[..., None] - b + ig
    m_loc = jnp.max(a, axis=-1)
    w_loc = jnp.exp(a - m_loc[..., None])
    kw = k * w_loc[..., None]
    C_loc = jnp.einsum('bhcsk,bhcsv->bhckv', kw, v)
    n_loc = jnp.sum(kw, axis=3)

    def step(carry, xs):
        C, n, m = carry
        C_l, n_l, m_l, bl = xs
        m_new = jnp.maximum(bl + m, m_l)
        s_old = jnp.exp(bl + m - m_new)
        s_loc = jnp.exp(m_l - m_new)
        C_new = s_old[..., None, None] * C + s_loc[..., None, None] * C_l
        n_new = s_old[..., None] * n + s_loc[..., None] * n_l
        return (C_new, n_new, m_new), (C, n, m)

    init = (jnp.zeros((B, H, DH, DH), F32), jnp.zeros((B, H, DH), F32), jnp.zeros((B, H), F32))
    xs = (jnp.moveaxis(C_loc, 2, 0), jnp.moveaxis(n_loc, 2, 0),
          jnp.moveaxis(m_loc, 2, 0), jnp.moveaxis(b_last, 2, 0))
    _, (C_prev, n_prev, m_prev) = lax.scan(step, init, xs)
    m_prev = jnp.transpose(m_prev, (1, 2, 0))

    g = b + m_prev[..., None]
    D = b[..., :, None] - b[..., None, :] + ig[..., None, :]
    mask = jnp.tril(jnp.ones((ML_CHUNK, ML_CHUNK), dtype=bool))
    D = jnp.where(mask, D, -jnp.inf)
    m_t = jnp.maximum(g, jnp.max(D, axis=-1))
    Sm = jnp.einsum('bhctd,bhcsd->bhcts', q, k) * jnp.exp(D - m_t[..., None])
    inter = jnp.exp(g - m_t)
    num = inter[..., None] * jnp.einsum('bhctk,cbhkv->bhctv', q, C_prev) \
        + jnp.einsum('bhcts,bhcsv->bhctv', Sm, v)
    den = inter * jnp.einsum('bhctk,cbhk->bhct', q, n_prev) + jnp.sum(Sm, axis=-1)
    h = num / jnp.maximum(jnp.abs(den), jnp.exp(-m_t))[..., None]
    return h.reshape(B, H, S, DH)


def mlstm_bidir(q, k, v, gates):
    B, S = q.shape[0], q.shape[1]
    g = gates.reshape(B, S, 4, ML_HEADS).transpose(2, 0, 3, 1)
    q, k, v = (a.transpose(0, 2, 1, 3) for a in (q, k, v))
    flip = lambda a: jnp.flip(a, axis=2)
    h_f = mlstm_chunkwise(q, k, v, g[0], g[1])
    h_b = flip(mlstm_chunkwise(flip(q), flip(k), flip(v), flip(g[2]), flip(g[3])))
    return (h_f + h_b).transpose(0, 2, 1, 3)


def encoder_layer(x, norm1_g, w_in, conv_w, conv_b, gate_b, filt_w1, filt_b1, filt_freq1,
                  filt_w2, filt_b2, filt_freq2, filt_w3, hy_bias, ml_norm_g, w_out,
                  norm2_g, w_up, ffn_conv_w, ffn_conv_b, w_down):
    B, S, _ = x.shape
    h = rmsnorm(x, norm1_g)
    proj = h @ w_in
    cp = dwconv3(proj[..., :CONV_CH], conv_w, conv_b)
    x1 = cp[..., :HY_WIDTH]
    x2 = cp[..., HY_WIDTH:2 * HY_WIDTH]
    hv = cp[..., 2 * HY_WIDTH:OFF_Q]
    kspec = hyena_filter_spectrum(S, filt_w1, filt_b1, filt_freq1, filt_w2, filt_b2, filt_freq2, filt_w3)
    y_hy = hyena_mix(x1, x2, hv, kspec, hy_bias).astype(x.dtype)
    q = jax.nn.silu(cp[..., OFF_Q:OFF_K].astype(F32)).reshape(B, S, ML_HEADS, ML_HEAD_DIM)
    k = (jax.nn.silu(cp[..., OFF_K:OFF_V].astype(F32)) * (ML_HEAD_DIM ** -0.5)).reshape(B, S, ML_HEADS, ML_HEAD_DIM)
    v = proj[..., OFF_V:OFF_O].astype(F32).reshape(B, S, ML_HEADS, ML_HEAD_DIM)
    o = jax.nn.sigmoid(proj[..., OFF_O:OFF_G].astype(F32))
    gates = proj[..., OFF_G:].astype(F32) + gate_b.astype(F32)
    hm = mlstm_bidir(q, k, v, gates)
    hm = hm * lax.rsqrt(jnp.mean(jnp.square(hm), axis=-1, keepdims=True) + EPS)
    hm = hm.reshape(B, S, ML_WIDTH) * ml_norm_g.astype(F32)
    y_ml = (o * hm).astype(x.dtype)
    x = x + jnp.concatenate([y_hy, y_ml], axis=-1) @ w_out
    h = rmsnorm(x, norm2_g)
    u = dwconv3(h @ w_up, ffn_conv_w, ffn_conv_b)
    val, gate = u[..., :D_FF], u[..., D_FF:]
    return x + (jax.nn.silu(gate) * val) @ w_down


def trunk(x, layer_params, final_g):
    for l in range(DEPTH):
        x = encoder_layer(x, *[p[l] for p in layer_params])
    return rmsnorm(x, final_g)


def setup_inputs(seed: int = 0) -> dict:
    key = jax.random.key(seed)
    ks = jax.random.split(key, 28)
    nrm = lambda k, shape, scale: jax.random.normal(k, shape, F32) * scale
    is_f = jnp.array([0.0, 1.0, 0.0, 1.0], F32)[None, :, None]
    gate_b = jnp.where(is_f > 0,
                       3.0 + 3.0 * jax.random.uniform(ks[5], (DEPTH, 4, ML_HEADS), F32),
                       0.1 * jax.random.normal(ks[6], (DEPTH, 4, ML_HEADS), F32)).reshape(DEPTH, N_GATE)
    return {
        "x_prompt": nrm(ks[0], (BATCH, SEQ, D_MODEL), 1.0),
        "x_sample": nrm(ks[1], (DEC_BATCH, DEC_SEQ, D_MODEL), 1.0),
        "norm1_g": 1.0 + nrm(ks[2], (DEPTH, D_MODEL), 0.02),
        "w_in": nrm(ks[3], (DEPTH, D_MODEL, P_IN), D_MODEL ** -0.5),
        "conv_w": nrm(ks[4], (DEPTH, 3, CONV_CH), 3 ** -0.5),
        "conv_b": nrm(ks[7], (DEPTH, CONV_CH), 0.02),
        "gate_b": gate_b,
        "filt_w1": nrm(ks[8], (DEPTH, HY_EMB, HY_FILTER_HIDDEN), HY_EMB ** -0.5),
        "filt_b1": nrm(ks[9], (DEPTH, HY_FILTER_HIDDEN), 0.1),
        "filt_freq1": 1.0 + nrm(ks[10], (DEPTH, HY_FILTER_HIDDEN), 0.1),
        "filt_w2": nrm(ks[11], (DEPTH, HY_FILTER_HIDDEN, HY_FILTER_HIDDEN), HY_FILTER_HIDDEN ** -0.5),
        "filt_b2": nrm(ks[12], (DEPTH, HY_FILTER_HIDDEN), 0.1),
        "filt_freq2": 1.0 + nrm(ks[13], (DEPTH, HY_FILTER_HIDDEN), 0.1),
        "filt_w3": nrm(ks[14], (DEPTH, HY_FILTER_HIDDEN, 2 * HY_ORDER * HY_WIDTH), HY_FILTER_HIDDEN ** -0.5),
        "hy_bias": nrm(ks[15], (DEPTH, HY_ORDER, HY_WIDTH), 0.1),
        "ml_norm_g": 1.0 + nrm(ks[16], (DEPTH, ML_WIDTH), 0.02),
        "w_out": nrm(ks[17], (DEPTH, MIX_WIDTH, D_MODEL), MIX_WIDTH ** -0.5),
        "norm2_g": 1.0 + nrm(ks[18], (DEPTH, D_MODEL), 0.02),
        "w_up": nrm(ks[19], (DEPTH, D_MODEL, 2 * D_FF), D_MODEL ** -0.5),
        "ffn_conv_w": nrm(ks[20], (DEPTH, 3, 2 * D_FF), 3 ** -0.5),
        "ffn_conv_b": nrm(ks[21], (DEPTH, 2 * D_FF), 0.02),
        "w_down": nrm(ks[22], (DEPTH, D_FF, D_MODEL), D_FF ** -0.5),
        "final_g": 1.0 + nrm(ks[23], (D_MODEL,), 0.02),
    }


def reference(x_prompt, x_sample, norm1_g, w_in, conv_w, conv_b, gate_b, filt_w1, filt_b1,
              filt_freq1, filt_w2, filt_b2, filt_freq2, filt_w3, hy_bias, ml_norm_g, w_out,
              norm2_g, w_up, ffn_conv_w, ffn_conv_b, w_down, final_g):
    layer_params = (norm1_g, w_in, conv_w, conv_b, gate_b, filt_w1, filt_b1, filt_freq1,
                    filt_w2, filt_b2, filt_freq2, filt_w3, hy_bias, ml_norm_g, w_out,
                    norm2_g, w_up, ffn_conv_w, ffn_conv_b, w_down)
    y_prompt = trunk(x_prompt, layer_params, final_g)
    y_sample = trunk(x_sample, layer_params, final_g)
    return (y_prompt, y_sample)
```

```cpp
#include <hip/hip_runtime.h>
#include <hip/hip_cooperative_groups.h>
#include <cstdio>
#include <cstdint>
namespace cg = cooperative_groups;

#define LAS __attribute__((address_space(3)))
typedef unsigned short bf16_t;
typedef short bf16x8 __attribute__((ext_vector_type(8)));
typedef short bf16x4 __attribute__((ext_vector_type(4)));
typedef float f32x4 __attribute__((ext_vector_type(4)));
typedef float f32x2 __attribute__((ext_vector_type(2)));
typedef unsigned u32x4 __attribute__((ext_vector_type(4)));
typedef unsigned u32x2 __attribute__((ext_vector_type(2)));

constexpr int MTOK = 98304, MPR = 32768, DM = 1024, NP1 = 3584, PIN = 3600, FF = 2816, FF2 = 5632;
constexpr size_t MiB = 1u << 20;
constexpr size_t HXN = (size_t)MTOK * 512;
constexpr size_t WS_CTL = 0;
constexpr size_t WS_W1T = 1 * MiB;
constexpr size_t WS_W2T = 8 * MiB;
constexpr size_t WS_W3T = 10 * MiB;
constexpr size_t WS_W4T = 21 * MiB;
constexpr size_t WS_HID = 27 * MiB;
constexpr size_t WS_GATES = 30 * MiB;
constexpr size_t WS_R1 = 36 * MiB;
constexpr size_t R1_PAD_ROWS = 256;
constexpr size_t WS_HX = 232 * MiB;
constexpr size_t WS_QKVO = 520 * MiB;
constexpr size_t WS_ACT = WS_HX;
constexpr size_t WS_YH = 904 * MiB;
constexpr size_t WS_H2U = 761 * MiB;
constexpr size_t WS_BAR = 512 * 1024;
constexpr size_t WS_SS2 = 560 * 1024;
constexpr size_t WS_SS = 4096;
constexpr size_t WS_END = 1000 * MiB;
static_assert(WS_H2U >= WS_ACT + (size_t)MTOK * FF * 2 + 2048 && WS_H2U + (size_t)(MTOK + 1024) * 2048 <= WS_END, "ws map");
static_assert(WS_R1 + (R1_PAD_ROWS + MTOK + 1024) * 2048 <= WS_HX, "ws map");
static_assert(WS_ACT + (size_t)MTOK * FF * 2 <= WS_YH, "ws map");
constexpr size_t OUT_SPEC0 = 0;
constexpr size_t OUT_SPEC1 = 128 * MiB;
constexpr size_t OUT_HF = 192 * MiB;
constexpr size_t OUT_HB = 288 * MiB;
constexpr size_t OUT_TAPS = OUT_HF;

constexpr int LDS_BYTES = 150528;

__device__ __forceinline__ unsigned pk2(float lo, float hi) { unsigned r; asm("v_cvt_pk_bf16_f32 %0, %1, %2" : "=v"(r) : "v"(lo), "v"(hi)); return r; }
__device__ __forceinline__ unsigned f2bf(float f) { return pk2(f, f) & 0xffffu; }
__device__ __forceinline__ float bflo(unsigned w) { return __builtin_bit_cast(float, w << 16); }
__device__ __forceinline__ float bfhi(unsigned w) { return __builtin_bit_cast(float, w & 0xffff0000u); }
__device__ __forceinline__ float bf1(bf16_t b) { return __builtin_bit_cast(float, ((unsigned)b) << 16); }
__device__ __forceinline__ int opaque_tid() { int t = (int)__builtin_amdgcn_workitem_id_x(); asm volatile("" : "+v"(t)); return t; }
__device__ __forceinline__ float xshfl(float v, int src) { return __builtin_bit_cast(float, __builtin_amdgcn_ds_bpermute(src << 2, __builtin_bit_cast(int, v))); }
__device__ __forceinline__ float xshfl_xor(float v, int m) { return xshfl(v, (opaque_tid() & 63) ^ m); }
__device__ __forceinline__ float wave_sum(float v) {
#pragma unroll
    for (int o = 1; o < 64; o <<= 1) v += xshfl_xor(v, o);
    return v;
}
__device__ __forceinline__ float fsigmoid(float x) { return __builtin_amdgcn_rcpf(1.f + __expf(-x)); }
__device__ __forceinline__ float sin_rad(float y) { return __builtin_amdgcn_sinf(__builtin_amdgcn_fractf(y * 0.15915494309189535f)); }
#define LDS_WAIT() asm volatile("s_waitcnt lgkmcnt(0)" ::: "memory")
#define LBAR() do { asm volatile("s_waitcnt lgkmcnt(0)" ::: "memory"); __builtin_amdgcn_s_barrier(); asm volatile("" ::: "memory"); } while (0)

namespace pg8 {
#define PG8_LAS __attribute__((address_space(3)))
constexpr int BM = 256, BK = 64, HALF = 128, HTB = HALF * BK * 2, STAGE_BYTES = 8 * HTB, NXCD = 8, WGM = 8;
__host__ __device__ __forceinline__ int lds_byte(int r, int c) { const int st = (r >> 4) * 2 + (c >> 5), rr = r & 15, cc = c & 31, ob = rr * 64 + cc * 2; return st * 1024 + (ob ^ (((ob >> 9) & 1) << 5)); }
__host__ __device__ __forceinline__ void stage_rc(int b, int& R, int& C) { const int st = b / 1024, sb = b % 1024, swz = sb ^ (((sb >> 9) & 1) << 5); R = (st >> 1) * 16 + swz / 64; C = (st & 1) * 32 + (swz % 64) / 2; }
__host__ __device__ __forceinline__ int perm32(int rho) { const int n = rho >> 4, i = rho & 15; return 8 * (i >> 2) + 4 * n + (i & 3); }
struct Unit { int pm, pn; };
struct Gemm { const bf16_t* A; const bf16_t* Bt; int K; int a_tile_rows; int a_row0; int a_half_rows; int amode; int span; };
struct StaticOrder {
    int nM, nN, nwg, G, c;
    __host__ __device__ void init(int nM_, int nN_, int G_, int c_) { nM = nM_; nN = nN_; nwg = nM * nN; G = G_; c = c_; }
    __host__ __device__ bool next(int i, Unit& u) const {
        const long L = (long)i * G + c; if (L >= nwg) return false;
        int wgid = (int)L; { const int q = nwg / NXCD, r = nwg % NXCD, xcd = wgid % NXCD, off = wgid / NXCD; wgid = (xcd < r ? xcd * (q + 1) : r * (q + 1) + (xcd - r) * q) + off; }
        const int nig = WGM * nN, gid = wgid / nig, fm = gid * WGM, gsz = (nM - fm) < WGM ? (nM - fm) : WGM;
        u.pm = fm + ((wgid % nig) % gsz); u.pn = (wgid % nig) / gsz; return true;
    }
};
__device__ __forceinline__ unsigned cvt_pk_bf16(float lo, float hi) { unsigned r; asm volatile("v_cvt_pk_bf16_f32 %0, %1, %2" : "=v"(r) : "v"(lo), "v"(hi)); return r; }

template <class Epi, class Sched, bool ALIGN_EPI = false, bool SP2 = false>
__device__ __forceinline__ void gemm_phase(PG8_LAS unsigned char* lds, const Gemm g, const Sched& S, const Epi& E) {
    const int tid = opaque_tid(), wid = __builtin_amdgcn_readfirstlane(tid >> 6), lane = tid & 63, wr = wid >> 2, wc = wid & 3, fr = lane & 15, fq = lane >> 4;
    const int K = g.K, nt = K / BK;
    unsigned voffA[2], voffB[2];
#pragma unroll
    for (int i = 0; i < 2; ++i) { int R, C; stage_rc(tid * 16 + i * 8192, R, C); const int Rb = Epi::PERM ? ((R & ~31) + perm32(R & 31)) : R;
        const int Ra = g.amode ? (g.span * (R >> 6) + 8 * (R & 15) + ((R >> 4) & 3)) : R;
        voffA[i] = (unsigned)(Ra * K + C) * 2u; voffB[i] = (unsigned)(Rb * K + C) * 2u; }
    const size_t kstep = (size_t)(BK * 2);
    const size_t hstepB = (size_t)HALF * K * 2;
    const size_t hstepA = (size_t)g.a_half_rows * K * 2;
    const size_t tstepB = 2 * hstepB;
    const unsigned ldsw = (unsigned)wid * 1024u;
    const int aoff = lds_byte(wr * 64 + fr, fq * 8), boff = lds_byte(wc * 32 + fr, fq * 8);
#define PG8_ABASE(pm) ((const char*)g.A + ((long)(pm) * g.a_tile_rows + g.a_row0) * (long)K * 2)
#define PG8_SA(b, h) (((b) * 2 + (h)) * HTB)
#define PG8_SB(b, h) ((4 + (b) * 2 + (h)) * HTB)
#define PG8_STAGE(bufoff, gbase, voff) do { _Pragma("unroll") for (int _i = 0; _i < 2; ++_i) \
        __builtin_amdgcn_global_load_lds((const unsigned*)((const char*)(gbase) + (voff)[_i]), (PG8_LAS unsigned*)(lds + (bufoff) + ldsw + _i * 8192), 16, 0, 0); } while (0)
#define PG8_LDA(dst, b, h) do { _Pragma("unroll") for (int m = 0; m < 4; ++m) _Pragma("unroll") for (int k = 0; k < 2; ++k) dst[m][k] = *(const PG8_LAS bf16x8*)(lds + PG8_SA(b, h) + aoff + m * 2048 + k * 1024); } while (0)
#define PG8_LDB(dst, b, h) do { _Pragma("unroll") for (int n = 0; n < 2; ++n) _Pragma("unroll") for (int k = 0; k < 2; ++k) dst[n][k] = *(const PG8_LAS bf16x8*)(lds + PG8_SB(b, h) + boff + n * 2048 + k * 1024); } while (0)
#define PG8_MMA(ai, bj, At, Bt) do { __builtin_amdgcn_s_setprio(1); _Pragma("unroll") for (int m = 0; m < 4; ++m) _Pragma("unroll") for (int n = 0; n < 2; ++n) _Pragma("unroll") for (int k = 0; k < 2; ++k) \
        acc[ai][bj][m][n] = __builtin_amdgcn_mfma_f32_16x16x32_bf16(Bt[n][k], At[m][k], acc[ai][bj][m][n], 0, 0, 0); __builtin_amdgcn_s_setprio(0); } while (0)
#define PG8_WAIT_V(n) asm volatile("s_waitcnt vmcnt(" #n ")" ::: "memory")
#define PG8_WAIT_L(n) asm volatile("s_waitcnt lgkmcnt(" #n ")" ::: "memory")
#define PG8_BAR __builtin_amdgcn_s_barrier()
#define PG8_SCHED __builtin_amdgcn_sched_barrier(0)
    Unit cur, nxt; int ui = 0;
    if (!S.next(0, cur)) return;
    f32x4 acc[2][2][4][2];
#pragma unroll
    for (int a = 0; a < 2; ++a)
#pragma unroll
        for (int b = 0; b < 2; ++b)
#pragma unroll
            for (int m = 0; m < 4; ++m)
#pragma unroll
                for (int n = 0; n < 2; ++n) acc[a][b][m][n] = (f32x4){0.f, 0.f, 0.f, 0.f};
    bf16x8 At[4][2], B0[2][2], B1[2][2];
    const char* cA = PG8_ABASE(cur.pm); const char* cB = (const char*)g.Bt + (size_t)cur.pn * tstepB;
    if constexpr (SP2) {
        PG8_STAGE(PG8_SB(0, 0), cB, voffB); PG8_STAGE(PG8_SB(0, 1), cB + hstepB, voffB); PG8_STAGE(PG8_SA(0, 0), cA, voffA); PG8_STAGE(PG8_SA(0, 1), cA + hstepA, voffA);
        if (wr == 1) PG8_BAR;
        PG8_WAIT_V(2); PG8_BAR;
        PG8_STAGE(PG8_SB(1, 0), cB + kstep, voffB); PG8_STAGE(PG8_SA(1, 0), cA + kstep, voffA); PG8_STAGE(PG8_SB(1, 1), cB + hstepB + kstep, voffB);
        PG8_WAIT_V(6); PG8_BAR;
    } else {
        PG8_STAGE(PG8_SB(0, 0), cB, voffB); PG8_STAGE(PG8_SA(0, 0), cA, voffA); PG8_STAGE(PG8_SB(0, 1), cB + hstepB, voffB); PG8_STAGE(PG8_SA(0, 1), cA + hstepA, voffA);
        if (wr == 1) PG8_BAR;
        PG8_WAIT_V(4); PG8_BAR;
        PG8_STAGE(PG8_SB(1, 0), cB + kstep, voffB); PG8_STAGE(PG8_SA(1, 0), cA + kstep, voffA); PG8_STAGE(PG8_SB(1, 1), cB + hstepB + kstep, voffB);
        PG8_WAIT_V(6); PG8_BAR;
    }
    for (;;) {
        const bool has_next = S.next(ui + 1, nxt);
        const char* nA = has_next ? PG8_ABASE(nxt.pm) : cA; const char* nB = has_next ? (const char*)g.Bt + (size_t)nxt.pn * tstepB : cB;
        for (int t = 0; t < nt; t += 2) {
            const bool last = (t == nt - 2);
            const char* a1 = cA + (size_t)(t + 1) * kstep;
            const char* a2 = last ? nA : cA + (size_t)(t + 2) * kstep; const char* b2 = last ? nB : cB + (size_t)(t + 2) * kstep;
            const char* a3 = a2 + kstep; const char* b3 = b2 + kstep;
            if constexpr (SP2) {
            PG8_LDB(B0, 0, 0); PG8_LDB(B1, 0, 1); PG8_SCHED; PG8_LDA(At, 0, 0); PG8_STAGE(PG8_SA(1, 1), a1 + hstepA, voffA);
            PG8_WAIT_V(8); PG8_WAIT_L(0); PG8_BAR; PG8_MMA(0, 0, At, B0); PG8_MMA(0, 1, At, B1); PG8_BAR; PG8_SCHED;
            PG8_LDA(At, 0, 1); PG8_STAGE(PG8_SB(0, 0), b2, voffB); PG8_STAGE(PG8_SB(0, 1), b2 + hstepB, voffB); PG8_STAGE(PG8_SA(0, 0), a2, voffA);
            PG8_WAIT_V(8); PG8_WAIT_L(0); PG8_BAR; PG8_MMA(1, 0, At, B0); PG8_MMA(1, 1, At, B1); PG8_BAR; PG8_SCHED;
            PG8_LDB(B0, 1, 0); PG8_LDB(B1, 1, 1); PG8_SCHED; PG8_LDA(At, 1, 0); PG8_STAGE(PG8_SA(0, 1), a2 + hstepA, voffA);
            PG8_WAIT_V(8); PG8_WAIT_L(0); PG8_BAR; PG8_MMA(0, 0, At, B0); PG8_MMA(0, 1, At, B1); PG8_BAR; PG8_SCHED;
            PG8_LDA(At, 1, 1); PG8_STAGE(PG8_SB(1, 0), b3, voffB); PG8_STAGE(PG8_SB(1, 1), b3 + hstepB, voffB); PG8_STAGE(PG8_SA(1, 0), a3, voffA);
            PG8_WAIT_V(8); PG8_WAIT_L(0); PG8_BAR; PG8_MMA(1, 0, At, B0); PG8_MMA(1, 1, At, B1); PG8_BAR; PG8_SCHED;
            } else {
            PG8_LDB(B0, 0, 0); PG8_SCHED; PG8_LDA(At, 0, 0); PG8_STAGE(PG8_SA(1, 1), a1 + hstepA, voffA);
            PG8_WAIT_L(8); PG8_BAR; PG8_WAIT_L(0); PG8_MMA(0, 0, At, B0); PG8_BAR; PG8_SCHED;
            PG8_LDB(B1, 0, 1); PG8_STAGE(PG8_SB(0, 0), b2, voffB);
            PG8_BAR; PG8_WAIT_L(0); PG8_MMA(0, 1, At, B1); PG8_BAR;
            PG8_LDA(At, 0, 1); PG8_STAGE(PG8_SA(0, 0), a2, voffA);
            PG8_BAR; PG8_WAIT_L(0); PG8_MMA(1, 0, At, B0); PG8_BAR; PG8_SCHED;
            PG8_STAGE(PG8_SB(0, 1), b2 + hstepB, voffB);
            PG8_WAIT_V(6); PG8_BAR; PG8_MMA(1, 1, At, B1); PG8_BAR;
            PG8_LDB(B0, 1, 0); PG8_SCHED; PG8_LDA(At, 1, 0); PG8_STAGE(PG8_SA(0, 1), a2 + hstepA, voffA);
            PG8_WAIT_L(8); PG8_BAR; PG8_WAIT_L(0); PG8_MMA(0, 0, At, B0); PG8_BAR; PG8_SCHED;
            PG8_LDB(B1, 1, 1); PG8_STAGE(PG8_SB(1, 0), b3, voffB);
            PG8_BAR; PG8_WAIT_L(0); PG8_MMA(0, 1, At, B1); PG8_BAR;
            PG8_LDA(At, 1, 1); PG8_STAGE(PG8_SA(1, 0), a3, voffA);
            PG8_BAR; PG8_WAIT_L(0); PG8_MMA(1, 0, At, B0); PG8_BAR; PG8_SCHED;
            PG8_STAGE(PG8_SB(1, 1), b3 + hstepB, voffB);
            PG8_WAIT_V(6); PG8_BAR; PG8_MMA(1, 1, At, B1); PG8_BAR;
            }
        }
        if constexpr (ALIGN_EPI) { if (wr == 0) PG8_BAR; }
        E(acc, cur, wr, wc, fr, fq);
        if (!has_next) break;
#pragma unroll
        for (int a = 0; a < 2; ++a)
#pragma unroll
            for (int b = 0; b < 2; ++b)
#pragma unroll
                for (int m = 0; m < 4; ++m)
#pragma unroll
                    for (int n = 0; n < 2; ++n) acc[a][b][m][n] = (f32x4){0.f, 0.f, 0.f, 0.f};
        cur = nxt; cA = nA; cB = nB; ++ui;
        if constexpr (ALIGN_EPI) { if (wr == 1) PG8_BAR; }
    }
    PG8_WAIT_V(0);
    if constexpr (!ALIGN_EPI) { if (wr == 0) PG8_BAR; }
    PG8_BAR;
#undef PG8_ABASE
#undef PG8_SA
#undef PG8_SB
#undef PG8_STAGE
#undef PG8_LDA
#undef PG8_LDB
#undef PG8_MMA
#undef PG8_WAIT_V
#undef PG8_WAIT_L
#undef PG8_BAR
#undef PG8_SCHED
}

struct EpiG1 {
    static constexpr bool PERM = true;
    bf16_t* HX; bf16_t* QKVO;
    __device__ __forceinline__ void operator()(f32x4 (&acc)[2][2][4][2], const Unit& u, int wr_, int wc_, int fr_, int fq_) const {
        const int tid_e = opaque_tid(), wid_e = __builtin_amdgcn_readfirstlane(tid_e >> 6), wr = wid_e >> 2, wc = wid_e & 3, fr = tid_e & 15, fq = (tid_e & 63) >> 4; (void)wr_; (void)wc_; (void)fr_; (void)fq_;
        const int tok0 = u.pm * 256 + wr * 128 + fr * 8;
        if (u.pn < 6) {
            bf16_t* T = HX + (size_t)(u.pn >> 1) * HXN;
            size_t sbase; int S, s;
            if (tok0 < MPR) { S = 8192; const int b = tok0 >> 13; s = tok0 & 8191; sbase = (size_t)b * 512 * 8192; }
            else { S = 4096; const int t2 = tok0 - MPR; const int b = t2 >> 12; s = t2 & 4095; sbase = (size_t)MPR * 512 + (size_t)b * 512 * 4096; }
            const int c0 = (u.pn & 1) * 256 + wc * 32 + 8 * fq;
#pragma unroll
            for (int bj = 0; bj < 2; ++bj)
#pragma unroll
                for (int n = 0; n < 2; ++n)
#pragma unroll
                    for (int e = 0; e < 4; ++e) {
                        const int c = c0 + bj * 128 + 4 * n + e;
                        u32x4 w;
                        w.x = cvt_pk_bf16(acc[0][bj][0][n][e], acc[0][bj][1][n][e]); w.y = cvt_pk_bf16(acc[0][bj][2][n][e], acc[0][bj][3][n][e]);
                        w.z = cvt_pk_bf16(acc[1][bj][0][n][e], acc[1][bj][1][n][e]); w.w = cvt_pk_bf16(acc[1][bj][2][n][e], acc[1][bj][3][n][e]);
                        *(u32x4*)(T + sbase + (size_t)c * S + s) = w;
                        if (e == 3) asm volatile("" ::: "memory");
                    }
        } else {
            const int cq0 = (u.pn - 6) * 256 + wc * 32 + 8 * fq;
            const bool sg = (u.pn >= 12);
#pragma unroll
            for (int ai = 0; ai < 2; ++ai)
#pragma unroll
                for (int m = 0; m < 4; ++m) {
                    bf16_t* rowp = QKVO + (size_t)(tok0 + ai * 4 + m) * 2048 + cq0;
#pragma unroll
                    for (int bj = 0; bj < 2; ++bj) {
                        f32x4 v0 = acc[ai][bj][m][0], v1 = acc[ai][bj][m][1];
                        if (sg) {
#pragma unroll
                            for (int e = 0; e < 4; ++e) { v0[e] = fsigmoid(v0[e]); v1[e] = fsigmoid(v1[e]); }
                        }
                        u32x4 w; w.x = cvt_pk_bf16(v0[0], v0[1]); w.y = cvt_pk_bf16(v0[2], v0[3]); w.z = cvt_pk_bf16(v1[0], v1[1]); w.w = cvt_pk_bf16(v1[2], v1[3]);
                        *(u32x4*)(rowp + bj * 128) = w;
                    }
                    asm volatile("" ::: "memory");
                }
        }
    }
};
struct EpiG2 {
    static constexpr bool PERM = true;
    const float* xp; const float* xs; float* out; const float* g2; bf16_t* H2U; float* SS;
    __device__ __forceinline__ void operator()(f32x4 (&acc)[2][2][4][2], const Unit& u, int wr_, int wc_, int fr_, int fq_) const {
        const int tid_e = opaque_tid(), wid_e = __builtin_amdgcn_readfirstlane(tid_e >> 6), wr = wid_e >> 2, wc = wid_e & 3, fr = tid_e & 15, fq = (tid_e & 63) >> 4; (void)wr_; (void)wc_; (void)fr_; (void)fq_;
        const int row0 = u.pm * 256 + wr * 64 + fr, col0 = u.pn * 256 + wc * 32 + 8 * fq;
        f32x4 gv[2][2];
#pragma unroll
        for (int bj = 0; bj < 2; ++bj)
#pragma unroll
            for (int n = 0; n < 2; ++n) gv[bj][n] = *(const f32x4*)(g2 + col0 + bj * 128 + 4 * n);
#pragma unroll
        for (int ai = 0; ai < 2; ++ai) {
            f32x4 xr4[4][2][2];
#pragma unroll
            for (int m = 0; m < 4; ++m) {
                const int row = row0 + ai * 128 + m * 16;
                const float* xr = (row < MPR ? xp + (size_t)row * DM : xs + (size_t)(row - MPR) * DM) + col0;
#pragma unroll
                for (int bj = 0; bj < 2; ++bj) { xr4[m][bj][0] = *(const f32x4*)(xr + bj * 128); xr4[m][bj][1] = *(const f32x4*)(xr + bj * 128 + 4); }
            }
#pragma unroll
            for (int m = 0; m < 4; ++m) {
                const int row = row0 + ai * 128 + m * 16;
                float* o = out + (size_t)row * DM + col0;
                bf16_t* hb = H2U + (size_t)row * DM + col0;
                float s = 0.f;
#pragma unroll
                for (int bj = 0; bj < 2; ++bj) {
                    const f32x4 v0 = xr4[m][bj][0] + acc[ai][bj][m][0], v1 = xr4[m][bj][1] + acc[ai][bj][m][1];
                    *(f32x4*)(o + bj * 128) = v0; *(f32x4*)(o + bj * 128 + 4) = v1;
                    s += (v0.x * v0.x + v0.y * v0.y) + (v0.z * v0.z + v0.w * v0.w) + (v1.x * v1.x + v1.y * v1.y) + (v1.z * v1.z + v1.w * v1.w);
                    const f32x4 h0 = v0 * gv[bj][0], h1 = v1 * gv[bj][1];
                    u32x4 w; w.x = cvt_pk_bf16(h0[0], h0[1]); w.y = cvt_pk_bf16(h0[2], h0[3]); w.z = cvt_pk_bf16(h1[0], h1[1]); w.w = cvt_pk_bf16(h1[2], h1[3]);
                    *(u32x4*)(hb + bj * 128) = w;
                }
                s += xshfl_xor(s, 16); s += xshfl_xor(s, 32);
                if (fq == 0) atomicAdd(SS + row, s);
            }
        }
    }
};
struct EpiG4 {
    static constexpr bool PERM = true;
    const float* xmid; bf16_t* OB; float* SS2;
    __device__ __forceinline__ void operator()(f32x4 (&acc)[2][2][4][2], const Unit& u, int wr_, int wc_, int fr_, int fq_) const {
        const int tid_e = opaque_tid(), wid_e = __builtin_amdgcn_readfirstlane(tid_e >> 6), wr = wid_e >> 2, wc = wid_e & 3, fr = tid_e & 15, fq = (tid_e & 63) >> 4; (void)wr_; (void)wc_; (void)fr_; (void)fq_;
        const int row0 = u.pm * 256 + wr * 64 + fr, col0 = u.pn * 256 + wc * 32 + 8 * fq;
#pragma unroll
        for (int ai = 0; ai < 2; ++ai) {
            f32x4 xr4[4][2][2];
#pragma unroll
            for (int m = 0; m < 4; ++m) {
                const float* o = xmid + (size_t)(row0 + ai * 128 + m * 16) * DM + col0;
#pragma unroll
                for (int bj = 0; bj < 2; ++bj) { xr4[m][bj][0] = *(const f32x4*)(o + bj * 128); xr4[m][bj][1] = *(const f32x4*)(o + bj * 128 + 4); }
            }
#pragma unroll
            for (int m = 0; m < 4; ++m) {
                const int row = row0 + ai * 128 + m * 16;
                bf16_t* ob = OB + (size_t)row * DM + col0;
                float s = 0.f;
#pragma unroll
                for (int bj = 0; bj < 2; ++bj) {
                    const f32x4 v0 = xr4[m][bj][0] + acc[ai][bj][m][0], v1 = xr4[m][bj][1] + acc[ai][bj][m][1];
                    s += (v0.x * v0.x + v0.y * v0.y) + (v0.z * v0.z + v0.w * v0.w) + (v1.x * v1.x + v1.y * v1.y) + (v1.z * v1.z + v1.w * v1.w);
                    u32x4 w; w.x = cvt_pk_bf16(v0[0], v0[1]); w.y = cvt_pk_bf16(v0[2], v0[3]); w.z = cvt_pk_bf16(v1[0], v1[1]); w.w = cvt_pk_bf16(v1[2], v1[3]);
                    *(u32x4*)(ob + bj * 128) = w;
                }
                s += xshfl_xor(s, 16); s += xshfl_xor(s, 32);
                if (fq == 0) atomicAdd(SS2 + row, s);
            }
        }
    }
};
__device__ __forceinline__ float dpp_row_shr1(float x) { return __builtin_bit_cast(float, __builtin_amdgcn_update_dpp(0, __builtin_bit_cast(int, x), 0x111, 0xf, 0xf, false)); }
__device__ __forceinline__ float dpp_row_shl1(float x) { return __builtin_bit_cast(float, __builtin_amdgcn_update_dpp(0, __builtin_bit_cast(int, x), 0x101, 0xf, 0xf, false)); }
__device__ __forceinline__ bool seq_start(int g) { return g < MPR ? ((g & 8191) == 0) : ((g & 4095) == 0); }
struct EpiG3 {
    static constexpr bool PERM = true;
    const float* cw; const float* cb; bf16_t* ACT; const float* SS;
    __device__ __forceinline__ void operator()(f32x4 (&acc)[2][2][4][2], const Unit& u, int wr_, int wc_, int fr_, int fq_) const {
        const int tid_e = opaque_tid(), wid_e = __builtin_amdgcn_readfirstlane(tid_e >> 6), wr = wid_e >> 2, wc = wid_e & 3, fr = tid_e & 15, fq = (tid_e & 63) >> 4; (void)wr_; (void)wc_; (void)fr_; (void)fq_;
        const int gbase = u.pm * 252 + wr * 126 + 8 * fr - 1;
        const int ch0 = u.pn * 128 + wc * 32 + 8 * fq;
        {
            const float* sp = SS + gbase;
            float rs[8];
#pragma unroll
            for (int i = 0; i < 8; ++i) rs[i] = sp[i];
#pragma unroll
            for (int i = 0; i < 8; ++i) {
                const float r = rsqrtf(rs[i] * (1.f / DM) + 1e-6f);
#pragma unroll
                for (int bj = 0; bj < 2; ++bj)
#pragma unroll
                    for (int n = 0; n < 2; ++n) acc[i >> 2][bj][i & 3][n] = acc[i >> 2][bj][i & 3][n] * r;
            }
            asm volatile("" ::: "memory");
        }
        f32x4 WV[2][4], WG[2][4];
#pragma unroll
        for (int n = 0; n < 2; ++n) {
#pragma unroll
            for (int r = 0; r < 3; ++r) { WV[n][r] = *(const f32x4*)(cw + r * FF2 + ch0 + 4 * n); WG[n][r] = *(const f32x4*)(cw + r * FF2 + FF + ch0 + 4 * n); }
            WV[n][3] = *(const f32x4*)(cb + ch0 + 4 * n); WG[n][3] = *(const f32x4*)(cb + FF + ch0 + 4 * n);
        }
        float dep = 0.f;
#pragma unroll
        for (int n = 0; n < 2; ++n)
#pragma unroll
            for (int e = 0; e < 4; ++e) {
                const float wv0 = WV[n][0][e], wv1 = WV[n][1][e], wv2 = WV[n][2][e], bv = WV[n][3][e];
                const float wg0 = WG[n][0][e], wg1 = WG[n][1][e], wg2 = WG[n][2][e], bg = WG[n][3][e];
                float s0 = acc[1][0][3][n][e], s1 = acc[0][0][0][n][e], s2 = acc[1][1][3][n][e], s3 = acc[0][1][0][n][e];
                asm volatile("" : "+v"(s0), "+v"(s1), "+v"(s2), "+v"(s3) : "v"(dep));
                const float Vp = dpp_row_shr1(s0), Vn = dpp_row_shl1(s1), Gp = dpp_row_shr1(s2), Gn = dpp_row_shl1(s3);
                float pv = Vp, pg = Gp;
#pragma unroll
                for (int i = 0; i < 8; ++i) {
                    const float cvv = acc[i >> 2][0][i & 3][n][e], cgg = acc[i >> 2][1][i & 3][n][e];
                    const float nv = (i == 7) ? Vn : acc[(i + 1 > 7 ? 7 : i + 1) >> 2][0][(i + 1 > 7 ? 7 : i + 1) & 3][n][e];
                    const float ng = (i == 7) ? Gn : acc[(i + 1 > 7 ? 7 : i + 1) >> 2][1][(i + 1 > 7 ? 7 : i + 1) & 3][n][e];
                    const bool sti = seq_start(gbase + i), eni = seq_start(gbase + i + 1);
                    const float cv = wv1 * cvv + bv + (sti ? 0.f : wv0 * pv) + (eni ? 0.f : wv2 * nv);
                    const float cgt = wg1 * cgg + bg + (sti ? 0.f : wg0 * pg) + (eni ? 0.f : wg2 * ng);
                    acc[i >> 2][0][i & 3][n][e] = cv * cgt * fsigmoid(cgt);
                    pv = cvv; pg = cgg;
                }
                dep = acc[1][0][3][n][e];
            }
#pragma unroll
        for (int i = 0; i < 8; ++i) {
            const int li = 8 * fr + i, g = gbase + i;
            if (li >= 1 && li <= 126 && g < MTOK) {
                const f32x4 v0 = acc[i >> 2][0][i & 3][0], v1 = acc[i >> 2][0][i & 3][1];
                u32x4 w; w.x = cvt_pk_bf16(v0[0], v0[1]); w.y = cvt_pk_bf16(v0[2], v0[3]); w.z = cvt_pk_bf16(v1[0], v1[1]); w.w = cvt_pk_bf16(v1[2], v1[3]);
                *(u32x4*)(ACT + (size_t)g * FF + ch0) = w;
            }
        }
    }
};
}

__device__ __forceinline__ int padidx(int p) { return p + ((p >> 6) << 2); }
__device__ __forceinline__ float cos16(int k) { switch (k & 7) { case 0: return 1.f; case 1: return 0.92387953251f; case 2: return 0.70710678119f; case 3: return 0.38268343237f; case 4: return 0.f; case 5: return -0.38268343237f; case 6: return -0.70710678119f; default: return -0.92387953251f; } }
__device__ __forceinline__ float sin16(int k) { switch (k & 7) { case 0: return 0.f; case 1: return 0.38268343237f; case 2: return 0.70710678119f; case 3: return 0.92387953251f; case 4: return 1.f; case 5: return 0.92387953251f; case 6: return 0.70710678119f; default: return 0.38268343237f; } }
template <int R> __device__ __forceinline__ constexpr int bitrev_r(int i) { int r = 0; for (int b = 1, c = R >> 1; b < R; b <<= 1, c >>= 1) if (i & b) r |= c; return r; }
typedef f32x2 cplx;
__device__ __forceinline__ cplx cmul(cplx a, cplx w) { const cplx sw = __builtin_shufflevector(a, a, 1, 0); return a * (cplx){w.x, w.x} + sw * (cplx){-w.y, w.y}; }
__device__ __forceinline__ cplx cmulc(cplx a, cplx w) { const cplx sw = __builtin_shufflevector(a, a, 1, 0); return a * (cplx){w.x, w.x} + sw * (cplx){w.y, -w.y}; }
template <int R, bool ZH> __device__ __forceinline__ void reg_fft_fwd(cplx (&x)[R]) {
#pragma unroll
    for (int half = R / 2; half >= 1; half >>= 1) {
#pragma unroll
        for (int i = 0; i < R; ++i) {
            if ((i & half) == 0) {
                const int j = i + half, k16 = (i & (half - 1)) * 8 / half;
                const cplx a = x[i], b = x[j];
                cplx d;
                if (ZH && half == R / 2) { d = a; } else { x[i] = a + b; d = a - b; }
                if (k16 == 0) x[j] = d;
                else if (k16 == 4) { cplx t; t.x = d.y; t.y = -d.x; x[j] = t; }
                else x[j] = cmulc(d, (cplx){cos16(k16), sin16(k16)});
            }
        }
    }
}
template <int R, bool OH> __device__ __forceinline__ void reg_fft_inv(cplx (&x)[R]) {
#pragma unroll
    for (int half = 1; half < R; half <<= 1) {
#pragma unroll
        for (int i = 0; i < R; ++i) {
            if ((i & half) == 0) {
                const int j = i + half, k16 = (i & (half - 1)) * 8 / half;
                const cplx a = x[i]; cplx b = x[j];
                if (k16 == 0) {}
                else if (k16 == 4) { cplx t; t.x = -b.y; t.y = b.x; b = t; }
                else b = cmul(b, (cplx){cos16(k16), sin16(k16)});
                x[i] = a + b;
                if (!(OH && half == R / 2)) x[j] = a - b;
            }
        }
    }
}
template <int R> __device__ __forceinline__ void tw_powers(cplx w1, cplx (&P)[R]) {
    P[0] = (cplx){1.f, 0.f}; P[1] = w1;
    if (R > 2) { P[2] = cmul(w1, w1); P[3] = cmul(P[2], w1); }
    if (R > 4) { P[4] = cmul(P[2], P[2]); P[5] = cmul(P[4], w1); P[6] = cmul(P[3], P[3]); P[7] = cmul(P[4], P[3]); }
    if (R > 8) { P[8] = cmul(P[4], P[4]); P[9] = cmul(P[8], w1); P[10] = cmul(P[5], P[5]); P[11] = cmul(P[8], P[3]); P[12] = cmul(P[6], P[6]); P[13] = cmul(P[8], P[5]); P[14] = cmul(P[7], P[7]); P[15] = cmul(P[8], P[7]); }
}
template <int R, bool INV, bool NOTW, bool HALF, int MBLK, int NN, int NZ = 1> __device__ __forceinline__ void fft_pass(LAS cplx* Z, const LAS cplx* TW) {
    constexpr int s = MBLK / R;
    constexpr int ZSTR = NN + NN / 16;
#define FOFF(k) ((k) * s + ((((k) * s) >> 6) << 2))
    constexpr int TSH = 16384 / MBLK;
    for (int t = opaque_tid(); t < NN / R; t += 512) {
        const int j = t % s, b0 = (t / s) * MBLK + j;
        LAS cplx* zp = Z + padidx(b0);
        cplx x[NZ][R]; cplx P[R];
        if (!INV) {
#pragma unroll
            for (int z = 0; z < NZ; ++z) {
#pragma unroll
                for (int k = 0; k < (HALF ? R / 2 : R); ++k) x[z][k] = zp[z * ZSTR + FOFF(k)];
                if (HALF) {
#pragma unroll
                    for (int k = R / 2; k < R; ++k) x[z][k] = (cplx){0.f, 0.f};
                }
            }
            if (!NOTW) tw_powers<R>(TW[j * TSH], P);
#pragma unroll
            for (int z = 0; z < NZ; ++z) {
                reg_fft_fwd<R, HALF>(x[z]);
#pragma unroll
                for (int i = 0; i < R; ++i) { const int q = bitrev_r<R>(i); zp[z * ZSTR + FOFF(q)] = (NOTW || q == 0) ? x[z][i] : cmulc(x[z][i], P[q]); }
            }
        } else {
#pragma unroll
            for (int z = 0; z < NZ; ++z)
#pragma unroll
                for (int i = 0; i < R; ++i) { const int q = bitrev_r<R>(i); x[z][i] = zp[z * ZSTR + FOFF(q)]; }
            if (!NOTW) tw_powers<R>(TW[j * TSH], P);
#pragma unroll
            for (int z = 0; z < NZ; ++z) {
                if (!NOTW) {
#pragma unroll
                    for (int i = 0; i < R; ++i) { const int q = bitrev_r<R>(i); if (q != 0) x[z][i] = cmul(x[z][i], P[q]); }
                }
                reg_fft_inv<R, HALF>(x[z]);
#pragma unroll
                for (int k = 0; k < (HALF ? R / 2 : R); ++k) zp[z * ZSTR + FOFF(k)] = x[z][k];
            }
        }
    }
    LBAR();
}
template <int NN> __device__ __forceinline__ void fft_fwd_full(LAS cplx* Z, const LAS cplx* TW) {
    fft_pass<16, false, false, false, NN, NN>(Z, TW); fft_pass<16, false, false, false, NN / 16, NN>(Z, TW); fft_pass<16, false, false, false, NN / 256, NN>(Z, TW);
    fft_pass<NN / 4096, false, true, false, NN / 4096, NN>(Z, TW);
}
template <int NN, int NZ> __device__ __forceinline__ void fft_conv(LAS cplx* Z, const LAS cplx* TW, const cplx* const (&Kp)[NZ]) {
    constexpr int R4 = NN / 4096, NIT = NN / R4 / 512, ZSTR = NN + NN / 16;
    const int tid = opaque_tid();
    f32x4 kk[NZ][NIT][R4 / 2];
#pragma unroll
    for (int z = 0; z < NZ; ++z)
#pragma unroll
        for (int i = 0; i < NIT; ++i)
#pragma unroll
            for (int h = 0; h < R4 / 2; ++h) kk[z][i][h] = *(const f32x4*)(Kp[z] + R4 * (tid + 512 * i) + 2 * h);
    fft_pass<16, false, false, true, NN, NN, NZ>(Z, TW); fft_pass<16, false, false, false, NN / 16, NN, NZ>(Z, TW); fft_pass<16, false, false, false, NN / 256, NN, NZ>(Z, TW);
#pragma unroll
    for (int z = 0; z < NZ; ++z)
#pragma unroll
        for (int i = 0; i < NIT; ++i) {
            LAS cplx* zp = Z + z * ZSTR + padidx(R4 * (tid + 512 * i));
            cplx x[R4], kc[R4];
#pragma unroll
            for (int h = 0; h < R4 / 2; ++h) { const f32x4 v = *(const LAS f32x4*)(zp + 2 * h); x[2 * h] = (cplx){v.x, v.y}; x[2 * h + 1] = (cplx){v.z, v.w}; kc[2 * h] = (cplx){kk[z][i][h].x, kk[z][i][h].y}; kc[2 * h + 1] = (cplx){kk[z][i][h].z, kk[z][i][h].w}; }
            reg_fft_fwd<R4, false>(x);
#pragma unroll
            for (int q = 0; q < R4; ++q) x[q] = cmul(x[q], kc[bitrev_r<R4>(q)]);
            reg_fft_inv<R4, false>(x);
#pragma unroll
            for (int h = 0; h < R4 / 2; ++h) { f32x4 v; v.x = x[2 * h].x; v.y = x[2 * h].y; v.z = x[2 * h + 1].x; v.w = x[2 * h + 1].y; *(LAS f32x4*)(zp + 2 * h) = v; }
        }
    LBAR();
    fft_pass<16, true, false, false, NN / 256, NN, NZ>(Z, TW); fft_pass<16, true, false, false, NN / 16, NN, NZ>(Z, TW); fft_pass<16, true, false, true, NN, NN, NZ>(Z, TW);
}
__device__ __forceinline__ void tw_init(LAS cplx* TW) {
    for (int j = opaque_tid(); j < 1024; j += 512) { const float r = (float)j * (1.0f / 16384.0f); cplx w; w.x = __builtin_amdgcn_cosf(r); w.y = __builtin_amdgcn_sinf(r); TW[j] = w; }
}

constexpr int FFT_LDS = (16384 + 1024) * 8;
constexpr int FFT_AUX = FFT_LDS;
constexpr int FFT_TW = FFT_LDS + 544;

__device__ __forceinline__ void taps_item(LAS unsigned char* lds, int it, const float* HID, const float* w3, unsigned char* outb) {
    const int tid = opaque_tid();
    int lsel, tt, ct;
    if (it < 512) { lsel = 0; tt = it >> 5; ct = it & 31; } else { lsel = 1; const int r = it - 512; tt = r >> 5; ct = r & 31; }
    const int L = lsel ? 4096 : 8192, t = tt * 512 + tid;
    LAS float* W = (LAS float*)lds;
    LBAR();
    for (int i = tid; i < 4096; i += 512) { const int j = i >> 6, c = i & 63; W[c * 64 + j] = w3[(size_t)j * 2048 + ct * 64 + c]; }
    f32x4 h[16];
    const f32x4* hr = (const f32x4*)(HID + ((lsel ? (size_t)8192 : 0) + t) * 64);
#pragma unroll
    for (int q = 0; q < 16; ++q) h[q] = hr[q];
    LBAR();
    float* dst = (float*)(outb + OUT_TAPS) + (lsel ? (size_t)2048 * 8192 : 0) + (size_t)(ct * 64) * L + t;
#pragma unroll 2
    for (int c = 0; c < 64; ++c) {
        float d0 = 0.f, d1 = 0.f;
#pragma unroll
        for (int q = 0; q < 16; ++q) { const f32x4 w = *(const LAS f32x4*)(W + c * 64 + 4 * q); d0 += h[q].x * w.x + h[q].z * w.z; d1 += h[q].y * w.y + h[q].w * w.w; }
        dst[(size_t)c * L] = d0 + d1;
    }
}

__device__ __forceinline__ void spectrum_item(LAS unsigned char* lds, int item, const float* hy_bias, unsigned char* outb) {
    const int tid = opaque_tid();
    const int lsel = item >> 10, order = (item >> 9) & 1, ch = item & 511;
    const int L = lsel ? 4096 : 8192, N = 2 * L;
    LAS f32x2* Z = (LAS f32x2*)lds; LAS cplx* TW = (LAS cplx*)(lds + FFT_TW); tw_init(TW);
    LAS float* aux = (LAS float*)(lds + FFT_AUX);
    const float* TF = (const float*)(outb + OUT_TAPS) + (lsel ? (size_t)2048 * 8192 : 0) + (size_t)(order * 512 + ch) * L;
    const float* TB = TF + (size_t)1024 * L;
    LBAR();
    const float delta = 3.0701134573253945f + (float)ch * ((15.350567286626973f - 3.0701134573253945f) / 511.0f);
    float ss = 0.f;
    for (int t0 = tid; t0 < L; t0 += 8 * 512) {
        float tf[8], tb[8];
#pragma unroll
        for (int i = 0; i < 8; ++i) { tf[i] = TF[t0 + 512 * i]; tb[i] = TB[t0 + 512 * i]; }
#pragma unroll
        for (int i = 0; i < 8; ++i) {
            const int t = t0 + 512 * i;
            const float dec = __expf(-((float)t / (float)(L - 1)) * delta);
            const float hf = tf[i] * dec, hb = tb[i] * dec;
            f32x2 o; o.y = 0.f; o.x = hf; Z[padidx(t)] = o; ss += hf * hf;
            if (t >= 1) { o.x = hb; Z[padidx(N - t)] = o; ss += hb * hb; }
        }
    }
    if (tid == 0) { f32x2 o; o.x = 0.f; o.y = 0.f; Z[padidx(L)] = o; }
    ss = wave_sum(ss);
    if ((tid & 63) == 0) aux[128 + (tid >> 6)] = ss;
    LBAR();
    float tot = 0.f;
#pragma unroll
    for (int w = 0; w < 8; ++w) tot += aux[128 + w];
    const float invN = 1.0f / (float)N;
    const float scale = rsqrtf(tot) * invN;
    for (int p = tid; p < N; p += 512) { f32x2 z = Z[padidx(p)]; z.x *= scale; if (p == 0) z.x += hy_bias[order * 512 + ch] * invN; Z[padidx(p)] = z; }
    LBAR();
    if (lsel) fft_fwd_full<8192>(Z, TW); else fft_fwd_full<16384>(Z, TW);
    f32x2* dst = (f32x2*)(outb + (lsel ? OUT_SPEC1 : OUT_SPEC0)) + (size_t)(order * 512 + ch) * N;
    for (int p = tid; p < N; p += 512) dst[p] = Z[padidx(p)];
    LBAR();
}

struct Raw8 { u32x4 raw; float left, right; };
__device__ __forceinline__ Raw8 load_raw8(const bf16_t* base, int n0, int L) {
    Raw8 r; r.raw = *(const u32x4*)(base + n0);
    r.left = n0 > 0 ? bf1(base[n0 - 1]) : 0.f; r.right = (n0 + 8 < L) ? bf1(base[n0 + 8]) : 0.f; return r;
}
__device__ __forceinline__ void conv_raw8(const Raw8& r, float w0, float w1, float w2, float b, float (&out)[8]) {
    float x[10]; x[0] = r.left; x[9] = r.right;
    x[1] = bflo(r.raw.x); x[2] = bfhi(r.raw.x); x[3] = bflo(r.raw.y); x[4] = bfhi(r.raw.y); x[5] = bflo(r.raw.z); x[6] = bfhi(r.raw.z); x[7] = bflo(r.raw.w); x[8] = bfhi(r.raw.w);
#pragma unroll
    for (int e = 0; e < 8; ++e) out[e] = w0 * x[e] + w1 * x[e + 1] + w2 * x[e + 2] + b;
}
template <int NN, int NZ> __device__ __forceinline__ void hyena_body(LAS unsigned char* lds, int pair, int ch0, const bf16_t* HX, bf16_t* YH, const float* conv_w, const float* conv_b, const unsigned char* outb) {
    constexpr int L = NN / 2, NIT = L / 8 / 512, lsel = (NN == 8192), ZSTR = NN + NN / 16;
    const int tid = opaque_tid();
    size_t sb[NZ][2];
    const cplx* K1[NZ]; const cplx* K2[NZ];
#pragma unroll
    for (int z = 0; z < NZ; ++z) {
        const int ch = ch0 + z;
#pragma unroll
        for (int bb = 0; bb < 2; ++bb) { const int b = 2 * pair + bb; sb[z][bb] = lsel ? ((size_t)MPR * 512 + ((size_t)b * 512 + ch) * 4096) : (((size_t)b * 512 + ch) * 8192); }
        K1[z] = (const f32x2*)(outb + (lsel ? OUT_SPEC1 : OUT_SPEC0)) + (size_t)ch * NN; K2[z] = K1[z] + (size_t)512 * NN;
    }
    LAS f32x2* Z = (LAS f32x2*)lds; LAS cplx* TW = (LAS cplx*)(lds + FFT_TW);
    const bf16_t* X1 = HX; const bf16_t* X2 = HX + HXN; const bf16_t* XV = HX + 2 * HXN;
    Raw8 rv[NZ][NIT][2], rx[NZ][NIT][2];
#pragma unroll
    for (int z = 0; z < NZ; ++z)
#pragma unroll
        for (int i = 0; i < NIT; ++i)
#pragma unroll
            for (int bb = 0; bb < 2; ++bb) { rv[z][i][bb] = load_raw8(XV + sb[z][bb], 8 * (tid + 512 * i), L); rx[z][i][bb] = load_raw8(X1 + sb[z][bb], 8 * (tid + 512 * i), L); }
    tw_init(TW);
#pragma unroll
    for (int z = 0; z < NZ; ++z) {
        const int ch = ch0 + z;
        const float w0 = conv_w[1024 + ch], w1 = conv_w[2560 + 1024 + ch], w2 = conv_w[2 * 2560 + 1024 + ch], bc = conv_b[1024 + ch];
#pragma unroll
        for (int i = 0; i < NIT; ++i) {
            const int n0 = 8 * (tid + 512 * i); float a[8], c[8];
            conv_raw8(rv[z][i][0], w0, w1, w2, bc, a); conv_raw8(rv[z][i][1], w0, w1, w2, bc, c);
#pragma unroll
            for (int e = 0; e < 4; ++e) { f32x4 o; o.x = a[2 * e]; o.y = c[2 * e]; o.z = a[2 * e + 1]; o.w = c[2 * e + 1]; *(LAS f32x4*)(Z + z * ZSTR + padidx(n0) + 2 * e) = o; }
        }
    }
    LBAR();
    fft_conv<NN, NZ>(Z, TW, K1);
#pragma unroll
    for (int z = 0; z < NZ; ++z) {
        const int ch = ch0 + z;
        const float w0 = conv_w[ch], w1 = conv_w[2560 + ch], w2 = conv_w[2 * 2560 + ch], bc = conv_b[ch];
#pragma unroll
        for (int i = 0; i < NIT; ++i) {
            const int n0 = 8 * (tid + 512 * i); float a[8], c[8];
            conv_raw8(rx[z][i][0], w0, w1, w2, bc, a); conv_raw8(rx[z][i][1], w0, w1, w2, bc, c);
#pragma unroll
            for (int e = 0; e < 4; ++e) { LAS f32x4* zp4 = (LAS f32x4*)(Z + z * ZSTR + padidx(n0) + 2 * e); const f32x4 y = *zp4; f32x4 o; o.x = a[2 * e] * y.x; o.y = c[2 * e] * y.y; o.z = a[2 * e + 1] * y.z; o.w = c[2 * e + 1] * y.w; *zp4 = o; }
        }
#pragma unroll
        for (int i = 0; i < NIT; ++i)
#pragma unroll
            for (int bb = 0; bb < 2; ++bb) rx[z][i][bb] = load_raw8(X2 + sb[z][bb], 8 * (tid + 512 * i), L);
    }
    LBAR();
    fft_conv<NN, NZ>(Z, TW, K2);
#pragma unroll
    for (int z = 0; z < NZ; ++z) {
        const int ch = ch0 + z;
        const float w0 = conv_w[512 + ch], w1 = conv_w[2560 + 512 + ch], w2 = conv_w[2 * 2560 + 512 + ch], bc = conv_b[512 + ch];
#pragma unroll
        for (int i = 0; i < NIT; ++i) {
            const int n0 = 8 * (tid + 512 * i); float a[8], c[8];
            conv_raw8(rx[z][i][0], w0, w1, w2, bc, a); conv_raw8(rx[z][i][1], w0, w1, w2, bc, c);
            float ya[8], yc[8];
#pragma unroll
            for (int e = 0; e < 4; ++e) { const f32x4 y = *(const LAS f32x4*)(Z + z * ZSTR + padidx(n0) + 2 * e); ya[2 * e] = a[2 * e] * y.x; yc[2 * e] = c[2 * e] * y.y; ya[2 * e + 1] = a[2 * e + 1] * y.z; yc[2 * e + 1] = c[2 * e + 1] * y.w; }
            u32x4 wa, wc2;
            wa.x = pk2(ya[0], ya[1]); wa.y = pk2(ya[2], ya[3]); wa.z = pk2(ya[4], ya[5]); wa.w = pk2(ya[6], ya[7]);
            wc2.x = pk2(yc[0], yc[1]); wc2.y = pk2(yc[2], yc[3]); wc2.z = pk2(yc[4], yc[5]); wc2.w = pk2(yc[6], yc[7]);
            *(u32x4*)(YH + sb[z][0] + n0) = wa; *(u32x4*)(YH + sb[z][1] + n0) = wc2;
        }
    }
    LBAR();
}
constexpr int HY_ITEMS = 1024 + 2048;
__device__ __forceinline__ void hyena_item(LAS unsigned char* lds, int item, const bf16_t* HX, bf16_t* YH, const float* conv_w, const float* conv_b, const unsigned char* outb) {
    if (item < 1024) hyena_body<16384, 1>(lds, item >> 9, item & 511, HX, YH, conv_w, conv_b, outb);
    else { const int r = 2 * (item - 1024); hyena_body<8192, 2>(lds, r >> 9, r & 511, HX, YH, conv_w, conv_b, outb); }
}

#define DPPF(oldv, x, ctrl, rmask) __builtin_bit_cast(float, __builtin_amdgcn_update_dpp(__builtin_bit_cast(int, (float)(oldv)), __builtin_bit_cast(int, (x)), (ctrl), (rmask), 0xf, false))
__device__ __forceinline__ float scan_add64(float x) {
    x += DPPF(0.f, x, 0x111, 0xf); x += DPPF(0.f, x, 0x112, 0xf); x += DPPF(0.f, x, 0x114, 0xf); x += DPPF(0.f, x, 0x118, 0xf);
    x += DPPF(0.f, x, 0x142, 0xa); x += DPPF(0.f, x, 0x143, 0xc); return x;
}
__device__ __forceinline__ float scan_max64(float x) {
    const float ninf = -__builtin_inff();
    x = fmaxf(x, DPPF(ninf, x, 0x111, 0xf)); x = fmaxf(x, DPPF(ninf, x, 0x112, 0xf)); x = fmaxf(x, DPPF(ninf, x, 0x114, 0xf)); x = fmaxf(x, DPPF(ninf, x, 0x118, 0xf));
    x = fmaxf(x, DPPF(ninf, x, 0x142, 0xa)); x = fmaxf(x, DPPF(ninf, x, 0x143, 0xc)); return x;
}
constexpr int ML_QS = 0, ML_KS = 17408, ML_KWT = 34816, ML_VT = 53248, ML_SM = 71680, ML_TOK = 80896  , ML_NV = 84992, ML_QN = 85504, ML_ROWS = 85760;
__device__ __forceinline__ void mlstm_item(LAS unsigned char* lds, int item, const bf16_t* QKVO, const bf16_t* QK2, const float* GATES, unsigned char* outb) {
    const int tid = opaque_tid(), lane = tid & 63, wave = tid >> 6, fr = lane & 15, fq = lane >> 4;
    int seq, head, dir, cfull, cend;
    if (item < 64) { const int r = item & 31; seq = r >> 3; head = (r >> 1) & 3; dir = r & 1; cfull = item < 32 ? 64 : 0; cend = item < 32 ? 128 : 64; }
    else { const int r = item - 64; seq = 4 + (r >> 3); head = (r >> 1) & 3; dir = r & 1; cfull = 0; cend = 64; }
    const int S = seq < 4 ? 8192 : 4096, tok_base = seq < 4 ? seq * 8192 : MPR + (seq - 4) * 4096, NC = cend;
    bf16_t* Hout = (bf16_t*)(outb + (dir ? OUT_HB : OUT_HF));
    LAS float* NV = (LAS float*)(lds + ML_NV); LAS float* QN = (LAS float*)(lds + ML_QN); LAS float* ROWS = (LAS float*)(lds + ML_ROWS);
    if (tid < 128) NV[tid] = 0.f;
    f32x4 Cacc[8];
#pragma unroll
    for (int k = 0; k < 8; ++k) Cacc[k] = (f32x4){0.f, 0.f, 0.f, 0.f};
    float m_prev = 0.f;
    const int lt = tid >> 3, dg = tid & 7;
    const int gidx_i = (dir * 2) * 4 + head, gidx_f = (dir * 2 + 1) * 4 + head;
    u32x4 rq[2], rk[2], rv[2]; float ig_n, fg_n;
    const int tokl = dir ? 63 - lane : lane;
    LAS f32x4* TOKS = (LAS f32x4*)(lds + ML_TOK);
#define ML_LOAD(cidx) do { const int c0_ = dir ? (S - 64 * ((cidx) + 1)) : 64 * (cidx); const size_t tk_ = (size_t)(tok_base + c0_ + lane); \
        const bf16_t* qp_ = QK2 + tk_ * 1024 + head * 128 + 16 * wave; const bf16_t* vp_ = QKVO + tk_ * 2048 + 1024 + head * 128 + 16 * wave; \
        rq[0] = *(const u32x4*)qp_; rq[1] = *(const u32x4*)(qp_ + 8); rk[0] = *(const u32x4*)(qp_ + 512); rk[1] = *(const u32x4*)(qp_ + 520); rv[0] = *(const u32x4*)vp_; rv[1] = *(const u32x4*)(vp_ + 8); \
        const float* gp_ = GATES + (size_t)(tok_base + c0_ + tokl) * 16; ig_n = gp_[gidx_i]; fg_n = gp_[gidx_f]; } while (0)
    ML_LOAD(0);
    LBAR();
    for (int c = 0; c < NC; ++c) {
        const int c0 = dir ? (S - 64 * (c + 1)) : 64 * c;
        const float ig = ig_n, fg = fg_n;
        const float lf = fminf(fg, 0.f) - __logf(1.f + __expf(-fabsf(fg)));
        const float bs = scan_add64(lf);
        const float uu = ig - bs;
        const float cu = scan_max64(uu);
        const float Mv = fmaxf(m_prev, cu);
        const float b_last = __builtin_bit_cast(float, __builtin_amdgcn_readlane(__builtin_bit_cast(int, bs), 63)), M_last = __builtin_bit_cast(float, __builtin_amdgcn_readlane(__builtin_bit_cast(int, Mv), 63));
        const float w_scan = __expf(uu - M_last), s_old = __expf(m_prev - M_last);
        if (wave == 0) { f32x4 tk; tk.x = __expf(m_prev - Mv); tk.y = __expf(fminf(-bs - Mv, 80.f)); tk.z = __expf(fminf(M_last - Mv, 60.f)); tk.w = 0.f; TOKS[tokl] = tk; }
        const float w_tok = dir ? xshfl(w_scan, 63 - lane) : w_scan;
        {
            LAS unsigned char* qrow = lds + ML_QS + lane * 272 + 32 * wave; LAS unsigned char* krow = lds + ML_KS + lane * 272 + 32 * wave;
            *(LAS u32x4*)qrow = rq[0]; *(LAS u32x4*)(qrow + 16) = rq[1];
            u32x4 kws[2];
#pragma unroll
            for (int h = 0; h < 2; ++h)
#pragma unroll
                for (int e = 0; e < 4; ++e) {
                    const int d = 16 * wave + 8 * h + 2 * e;
                    const unsigned kw = pk2(bflo(rk[h][e]) * w_tok, bfhi(rk[h][e]) * w_tok); kws[h][e] = kw;
                    *(LAS bf16_t*)(lds + ML_KWT + d * 144 + lane * 2) = (bf16_t)(kw & 0xffffu);
                    *(LAS bf16_t*)(lds + ML_KWT + (d + 1) * 144 + lane * 2) = (bf16_t)(kw >> 16);
                    *(LAS bf16_t*)(lds + ML_VT + d * 144 + lane * 2) = (bf16_t)(rv[h][e] & 0xffffu);
                    *(LAS bf16_t*)(lds + ML_VT + (d + 1) * 144 + lane * 2) = (bf16_t)(rv[h][e] >> 16);
                }
            *(LAS u32x4*)krow = kws[0]; *(LAS u32x4*)(krow + 16) = kws[1];
        }
        LBAR();
        if (c + 1 < NC) ML_LOAD(c + 1);
        const bool full = (c >= cfull);
        if (full) {
            const int rt = wave >> 1, ct0 = 2 * (wave & 1);
            f32x4 sacc[2] = {(f32x4){0.f, 0.f, 0.f, 0.f}, (f32x4){0.f, 0.f, 0.f, 0.f}};
#pragma unroll
            for (int ks = 0; ks < 4; ++ks) {
                const bf16x8 qf = *(const LAS bf16x8*)(lds + ML_QS + (16 * rt + fr) * 272 + (32 * ks + 8 * fq) * 2);
#pragma unroll
                for (int cc = 0; cc < 2; ++cc) { const bf16x8 kf = *(const LAS bf16x8*)(lds + ML_KS + (16 * (ct0 + cc) + fr) * 272 + (32 * ks + 8 * fq) * 2); sacc[cc] = __builtin_amdgcn_mfma_f32_16x16x32_bf16(kf, qf, sacc[cc], 0, 0, 0); }
            }
            const int t = 16 * rt + fr;
            const float rT = TOKS[t].z;
            float rs = 0.f;
#pragma unroll
            for (int cc = 0; cc < 2; ++cc) {
                float sv[4];
#pragma unroll
                for (int j = 0; j < 4; ++j) { const int s = 16 * (ct0 + cc) + 4 * fq + j; const bool keep = dir ? (s >= t) : (s <= t); const float v = keep ? sacc[cc][j] * rT : 0.f; sv[j] = v; rs += v; }
                u32x2 w; w.x = pk2(sv[0], sv[1]); w.y = pk2(sv[2], sv[3]);
                *(LAS u32x2*)(lds + ML_SM + t * 144 + (16 * (ct0 + cc) + 4 * fq) * 2) = w;
            }
            rs += xshfl_xor(rs, 16); rs += xshfl_xor(rs, 32);
            if (fq == 0) ROWS[t * 2 + (wave & 1)] = rs;
            float qd = 0.f;
            const u32x4 q0 = *(const LAS u32x4*)(lds + ML_QS + lt * 272 + 32 * dg), q1 = *(const LAS u32x4*)(lds + ML_QS + lt * 272 + 32 * dg + 16);
#pragma unroll
            for (int e = 0; e < 4; ++e) { qd += bflo(q0[e]) * NV[16 * dg + 2 * e] + bfhi(q0[e]) * NV[16 * dg + 2 * e + 1]; qd += bflo(q1[e]) * NV[16 * dg + 8 + 2 * e] + bfhi(q1[e]) * NV[16 * dg + 8 + 2 * e + 1]; }
            qd += DPPF(0.f, qd, 0x101, 0xf); qd += DPPF(0.f, qd, 0x102, 0xf); qd += DPPF(0.f, qd, 0x104, 0xf);
            if (dg == 0) QN[lt] = qd;
        }
        if (full) LBAR();
        {
            bf16x8 vf[2];
#pragma unroll
            for (int ks = 0; ks < 2; ++ks) vf[ks] = *(const LAS bf16x8*)(lds + ML_VT + (16 * wave + fr) * 144 + (32 * ks + 8 * fq) * 2);
            if (full) {
            bf16x8 cf[4];
#pragma unroll
            for (int ks = 0; ks < 4; ++ks) {
                u32x4 w; w.x = pk2(Cacc[2 * ks][0], Cacc[2 * ks][1]); w.y = pk2(Cacc[2 * ks][2], Cacc[2 * ks][3]); w.z = pk2(Cacc[2 * ks + 1][0], Cacc[2 * ks + 1][1]); w.w = pk2(Cacc[2 * ks + 1][2], Cacc[2 * ks + 1][3]);
                cf[ks] = __builtin_bit_cast(bf16x8, w);
            }
#pragma unroll
            for (int rt = 0; rt < 4; ++rt) {
                f32x4 o2 = (f32x4){0.f, 0.f, 0.f, 0.f}, o1 = (f32x4){0.f, 0.f, 0.f, 0.f};
#pragma unroll
                for (int ks = 0; ks < 2; ++ks) { const bf16x8 sf = *(const LAS bf16x8*)(lds + ML_SM + (16 * rt + fr) * 144 + (32 * ks + 8 * fq) * 2); o2 = __builtin_amdgcn_mfma_f32_16x16x32_bf16(vf[ks], sf, o2, 0, 0, 0); }
#pragma unroll
                for (int ks = 0; ks < 4; ++ks) {
                    const u32x2 qlo = *(const LAS u32x2*)(lds + ML_QS + (16 * rt + fr) * 272 + (32 * ks + 4 * fq) * 2), qhi = *(const LAS u32x2*)(lds + ML_QS + (16 * rt + fr) * 272 + (32 * ks + 16 + 4 * fq) * 2);
                    u32x4 w; w.x = qlo.x; w.y = qlo.y; w.z = qhi.x; w.w = qhi.y;
                    o1 = __builtin_amdgcn_mfma_f32_16x16x32_bf16(cf[ks], __builtin_bit_cast(bf16x8, w), o1, 0, 0, 0);
                }
                const int t = 16 * rt + fr;
                const f32x4 tk = TOKS[t]; const float it = tk.x, el = tk.y;
                const float den = it * QN[t] + ROWS[2 * t] + ROWS[2 * t + 1];
                const float r = __builtin_amdgcn_rcpf(fmaxf(fabsf(den), el));
                u32x2 w; w.x = pk2((it * o1[0] + o2[0]) * r, (it * o1[1] + o2[1]) * r); w.y = pk2((it * o1[2] + o2[2]) * r, (it * o1[3] + o2[3]) * r);
                *(u32x2*)(Hout + (size_t)(tok_base + c0 + t) * 512 + head * 128 + 16 * wave + 4 * fq) = w;
            }
            }
#pragma unroll
            for (int kt = 0; kt < 8; ++kt) {
                Cacc[kt] = Cacc[kt] * s_old;
#pragma unroll
                for (int ks = 0; ks < 2; ++ks) { const bf16x8 kwf = *(const LAS bf16x8*)(lds + ML_KWT + (16 * kt + fr) * 144 + (32 * ks + 8 * fq) * 2); Cacc[kt] = __builtin_amdgcn_mfma_f32_16x16x32_bf16(kwf, vf[ks], Cacc[kt], 0, 0, 0); }
                if (kt & 1) asm volatile("" ::: "memory");
            }
            const int d = tid >> 2, part = tid & 3;
            const u32x4 k0 = *(const LAS u32x4*)(lds + ML_KWT + d * 144 + part * 32), k1 = *(const LAS u32x4*)(lds + ML_KWT + d * 144 + part * 32 + 16);
            float sm = 0.f;
#pragma unroll
            for (int e = 0; e < 4; ++e) sm += bflo(k0[e]) + bfhi(k0[e]) + bflo(k1[e]) + bfhi(k1[e]);
            sm += DPPF(0.f, sm, 0x101, 0xf); sm += DPPF(0.f, sm, 0x102, 0xf);
            if (part == 0) NV[d] = s_old * NV[d] + sm;
        }
        m_prev = b_last + M_last;
        LBAR();
    }
#undef ML_LOAD
}

#define XB_TMO      128
#define XB_XCNT(j)  (256  + 64 * (j))
#define XB_XSUB(j)  (1280 + 64 * (j))
#define XB_XGEN(j)  (2304 + 64 * (j))
#define XB_TOP      3328
#define XB_TOPGEN   3392
#define XCD_BAR_WORDS 3456
#define XB_SPIN_CAP (1u << 22)
__device__ __forceinline__ unsigned xb_ld(unsigned* p)              { return __hip_atomic_load(p, __ATOMIC_RELAXED, __HIP_MEMORY_SCOPE_AGENT); }
__device__ __forceinline__ unsigned xb_add(unsigned* p, unsigned v) { return __hip_atomic_fetch_add(p, v, __ATOMIC_RELAXED, __HIP_MEMORY_SCOPE_AGENT); }
__device__ __forceinline__ unsigned xb_xcc_id() { return (unsigned)__builtin_amdgcn_s_getreg((3 << 11) | 20) & 0xFu; }
#define XB_SPIN(cond, bar) do { unsigned _sp = 0; while (cond) { __builtin_amdgcn_s_sleep(1); \
    if ((++_sp & 255u) == 0u) { if (xb_ld(&(bar)[XB_TMO])) break; if (_sp > XB_SPIN_CAP) { atomicAdd(&(bar)[XB_TMO], 1u); break; } } } } while (0)
struct XcdBarrier { unsigned* bar; unsigned x; volatile LAS unsigned* st; };
__device__ __forceinline__ XcdBarrier xcd_barrier_post(unsigned* bar, volatile LAS unsigned* st) {
    XcdBarrier b; b.bar = bar; b.x = xb_xcc_id(); b.st = st;
    if (opaque_tid() == 0) (void)xb_add(&bar[XB_XCNT(b.x)], 1u);
    return b;
}
__device__ __forceinline__ void xcd_barrier_complete(unsigned* bar, unsigned x, unsigned& nloc, unsigned& nx) {
    const unsigned G = gridDim.x * gridDim.y * gridDim.z;
    unsigned sum, cnt, mine, sp = 0u;
    for (;;) {
        sum = 0u; cnt = 0u; mine = 0u;
#pragma unroll
        for (unsigned j = 0; j < 16; ++j) { const unsigned c = xb_ld(&bar[XB_XCNT(j)]); sum += c; cnt += (c > 0u) ? 1u : 0u; mine = (j == x) ? c : mine; }
        if (sum == G) break;
        __builtin_amdgcn_s_sleep(1);
        if ((++sp & 255u) == 0u) { if (xb_ld(&bar[XB_TMO])) break; if (sp > XB_SPIN_CAP) { atomicAdd(&bar[XB_TMO], 1u); break; } }
    }
    nloc = mine > 0u ? mine : 1u; nx = cnt > 0u ? cnt : 1u;
}
__device__ __forceinline__ void xcd_barrier(const XcdBarrier& b) {
    asm volatile("s_waitcnt vmcnt(0)" ::: "memory");
    __syncthreads();
    if (opaque_tid() == 0) {
        unsigned* bar = b.bar;
        __builtin_amdgcn_s_waitcnt(0);
        unsigned nloc = b.st[0], nx = b.st[1];
        if (nloc == 0u) { xcd_barrier_complete(bar, b.x, nloc, nx); b.st[0] = nloc; b.st[1] = nx; }
        const unsigned old = xb_add(&bar[XB_XSUB(b.x)], 1u);
        const unsigned gen = old / nloc;
        if (old + 1u == (gen + 1u) * nloc) {
            __builtin_amdgcn_fence(__ATOMIC_RELEASE, "agent");
            asm volatile("s_waitcnt vmcnt(0)" ::: "memory");
            const unsigned og = xb_add(&bar[XB_TOP], 1u);
            const unsigned tg = og / nx;
            if (og + 1u == (tg + 1u) * nx) xb_add(&bar[XB_TOPGEN], 1u);
            else XB_SPIN(xb_ld(&bar[XB_TOPGEN]) == tg, bar);
            __builtin_amdgcn_fence(__ATOMIC_ACQUIRE, "agent");
            xb_add(&bar[XB_XGEN(b.x)], 1u);
            asm volatile("s_waitcnt vmcnt(0)" ::: "memory");
        } else {
            XB_SPIN(xb_ld(&bar[XB_XGEN(b.x)]) == gen, bar);
            __builtin_amdgcn_fence(__ATOMIC_ACQUIRE, "agent");
            asm volatile("s_waitcnt vmcnt(0)" ::: "memory");
        }
    }
    __syncthreads();
}

struct Args { const float* in[23]; float* out; unsigned char* ws; };

__device__ __forceinline__ void transpose_item(const float* W, int pitch, int K, bf16_t* WT, int n0, int dst_row0, int k0, LAS float* scr, int lane) {
#pragma unroll 8
    for (int i = 0; i < 32; ++i) { const int kk = 2 * i + (lane >> 5); scr[kk * 33 + (lane & 31)] = W[(size_t)(k0 + kk) * pitch + n0 + (lane & 31)]; }
    LDS_WAIT(); asm volatile("" ::: "memory");
    const int c = lane & 7;
#pragma unroll
    for (int j = 0; j < 4; ++j) { const int n = (lane >> 3) + 8 * j; const LAS float* s = scr + (8 * c) * 33 + n;
        u32x4 o; o.x = pk2(s[0 * 33], s[1 * 33]); o.y = pk2(s[2 * 33], s[3 * 33]); o.z = pk2(s[4 * 33], s[5 * 33]); o.w = pk2(s[6 * 33], s[7 * 33]);
        *(u32x4*)(WT + (size_t)(dst_row0 + n) * K + k0 + 8 * c) = o; }
    LDS_WAIT(); asm volatile("" ::: "memory");
}

__global__ void __launch_bounds__(512, 2) fwd_kernel(Args a) {
    extern __shared__ __attribute__((aligned(16))) unsigned char lds_raw[];
    LAS unsigned char* lds = (LAS unsigned char*)lds_raw;
    cg::grid_group grid = cg::this_grid();
#define PHASE_IDS const int tid = opaque_tid(), lane = tid & 63, wave = __builtin_amdgcn_readfirstlane(tid >> 6); const int gw = blockIdx.x * 8 + wave, NGW = G * 8; (void)lane; (void)gw; (void)NGW; (void)tid
    const int G = gridDim.x;
    LAS unsigned* bst = (LAS unsigned*)(lds + LDS_BYTES - 32);
    if (opaque_tid() == 0) { bst[0] = 0u; bst[1] = 0u; }
    __syncthreads();
    const XcdBarrier xbar = xcd_barrier_post((unsigned*)(a.ws + WS_BAR), (volatile LAS unsigned*)bst);
#define GSYNC() xcd_barrier(xbar)
    unsigned char* ws = a.ws; unsigned char* outb = (unsigned char*)a.out;
    unsigned* ctl = (unsigned*)(ws + WS_CTL);
    bf16_t* W1T = (bf16_t*)(ws + WS_W1T); bf16_t* W2T = (bf16_t*)(ws + WS_W2T); bf16_t* W3T = (bf16_t*)(ws + WS_W3T); bf16_t* W4T = (bf16_t*)(ws + WS_W4T);
    float* HID = (float*)(ws + WS_HID); float* GATES = (float*)(ws + WS_GATES);
    bf16_t* R1 = (bf16_t*)(ws + WS_R1) + R1_PAD_ROWS * 1024;
    bf16_t* YH = (bf16_t*)(ws + WS_YH); bf16_t* HX = (bf16_t*)(ws + WS_HX); bf16_t* QKVO = (bf16_t*)(ws + WS_QKVO); bf16_t* ACT = (bf16_t*)(ws + WS_ACT);
    const float* xp = a.in[0]; const float* xs = a.in[1];
    bf16_t* H2U = (bf16_t*)(ws + WS_H2U); float* SS = (float*)(ws + WS_SS); float* SS2 = (float*)(ws + WS_SS2);

    {
        PHASE_IDS;
        if (blockIdx.x == 0 && tid == 0) { ctl[0] = 0u; }
        for (int i = blockIdx.x * 512 + tid - 1; i < MTOK + 512; i += G * 512) SS[i] = 0.f;
        for (int i = blockIdx.x * 512 + tid; i < MTOK; i += G * 512) SS2[i] = 0.f;
#ifdef REP_P0
        for (int rep_ = 0; rep_ < 2; ++rep_) {
#endif
        LAS float* scr = (LAS float*)(lds + wave * 8448);
        constexpr int I1 = 16 * 112, I2 = 16 * 32, I3 = 16 * 176, I4 = 44 * 32;
        for (int it = gw; it < I1 + I2 + I3 + I4; it += NGW) {
            int r = it;
            if (r < I1) { const int kb = r / 112, nb = r % 112; transpose_item(a.in[3], PIN, 1024, W1T, 32 * nb, 32 * nb, 64 * kb, scr, lane); continue; } r -= I1;
            if (r < I2) { const int kb = r / 32, nb = r % 32; transpose_item(a.in[16], 1024, 1024, W2T, 32 * nb, 32 * nb, 64 * kb, scr, lane); continue; } r -= I2;
            if (r < I3) { const int kb = r / 176, nb = r % 176; const int n0 = 32 * nb; const int gate = n0 >= FF, cc = gate ? n0 - FF : n0; const int drow = (cc >> 7) * 256 + gate * 128 + (cc & 127);
                transpose_item(a.in[18], FF2, 1024, W3T, n0, drow, 64 * kb, scr, lane); continue; } r -= I3;
            { const int kb = r / 32, nb = r % 32; transpose_item(a.in[21], 1024, FF, W4T, 32 * nb, 32 * nb, 64 * kb, scr, lane); }
        }
        __syncthreads();
        LAS float* GWl = (LAS float*)(lds + 69632);
        for (int i = tid; i < 16 * 1024; i += 512) { const int k = i >> 4, gt = i & 15; GWl[gt * 1024 + k] = a.in[3][(size_t)k * PIN + NP1 + gt]; }
        __syncthreads();
        f32x4 g1[4];
#pragma unroll
        for (int j = 0; j < 4; ++j) g1[j] = ((const f32x4*)a.in[2])[lane + 64 * j];
        f32x4 nx[2][4];
#define P0_LOAD(mm) do { _Pragma("unroll") for (int r_ = 0; r_ < 2; ++r_) { const int mr_ = (mm) + r_; const float* xrow_ = mr_ < MPR ? xp + (size_t)mr_ * DM : xs + (size_t)(mr_ - MPR) * DM; \
            _Pragma("unroll") for (int j_ = 0; j_ < 4; ++j_) nx[r_][j_] = ((const f32x4*)xrow_)[lane + 64 * j_]; } } while (0)
        if (2 * gw < MTOK) P0_LOAD(2 * gw);
        for (int m = 2 * gw; m < MTOK; m += 2 * NGW) {
            f32x4 v[2][4];
#pragma unroll
            for (int r = 0; r < 2; ++r)
#pragma unroll
                for (int j = 0; j < 4; ++j) v[r][j] = nx[r][j];
            if (m + 2 * NGW < MTOK) P0_LOAD(m + 2 * NGW);
#pragma unroll
            for (int r = 0; r < 2; ++r) {
                const int mr = m + r;
                float s = 0.f;
#pragma unroll
                for (int j = 0; j < 4; ++j) s += (v[r][j].x * v[r][j].x + v[r][j].y * v[r][j].y) + (v[r][j].z * v[r][j].z + v[r][j].w * v[r][j].w);
                const float rs = rsqrtf(wave_sum(s) * (1.f / DM) + 1e-6f);
                unsigned long long* o8 = (unsigned long long*)(R1 + (size_t)mr * DM) + lane;
#pragma unroll
                for (int j = 0; j < 4; ++j) { v[r][j] = v[r][j] * rs * g1[j]; o8[64 * j] = (unsigned long long)pk2(v[r][j].x, v[r][j].y) | ((unsigned long long)pk2(v[r][j].z, v[r][j].w) << 32); }
            }
            float p[32];
#pragma unroll
            for (int gt = 0; gt < 16; ++gt) {
                float p0 = 0.f, p1 = 0.f;
#pragma unroll
                for (int j = 0; j < 4; ++j) { const f32x4 w = *(const LAS f32x4*)(GWl + gt * 1024 + 256 * j + 4 * lane);
                    p0 += (v[0][j].x * w.x + v[0][j].y * w.y) + (v[0][j].z * w.z + v[0][j].w * w.w); p1 += (v[1][j].x * w.x + v[1][j].y * w.y) + (v[1][j].z * w.z + v[1][j].w * w.w); }
                p[gt] = p0; p[16 + gt] = p1;
                if ((gt & 3) == 3) asm volatile("" ::: "memory");
            }
            { const bool hi = (lane & 32) != 0;
#pragma unroll
              for (int g = 0; g < 16; ++g) { const float mine = hi ? p[16 + g] : p[g], oth = hi ? p[g] : p[16 + g]; p[g] = mine + xshfl_xor(oth, 32); } }
            { const bool hi = (lane & 16) != 0;
#pragma unroll
              for (int g = 0; g < 8; ++g) { const float mine = hi ? p[8 + g] : p[g], oth = hi ? p[g] : p[8 + g]; p[g] = mine + xshfl_xor(oth, 16); } }
            { const bool hi = (lane & 8) != 0;
#pragma unroll
              for (int g = 0; g < 4; ++g) { const float mine = hi ? p[4 + g] : p[g], oth = hi ? p[g] : p[4 + g]; p[g] = mine + xshfl_xor(oth, 8); } }
            { const bool hi = (lane & 4) != 0;
#pragma unroll
              for (int g = 0; g < 2; ++g) { const float mine = hi ? p[2 + g] : p[g], oth = hi ? p[g] : p[2 + g]; p[g] = mine + xshfl_xor(oth, 4); } }
            { const bool hi = (lane & 2) != 0; const float mine = hi ? p[1] : p[0], oth = hi ? p[0] : p[1]; p[0] = mine + xshfl_xor(oth, 2); }
            p[0] += xshfl_xor(p[0], 1);
            const int gate = ((lane >> 4) & 1) * 8 + ((lane >> 3) & 1) * 4 + ((lane >> 2) & 1) * 2 + ((lane >> 1) & 1);
            if ((lane & 1) == 0) GATES[(size_t)(m + (lane >> 5)) * 16 + gate] = p[0] + a.in[6][gate];
        }
        for (int pos = gw; pos < 12288; pos += NGW) {
            const int L = pos < 8192 ? 8192 : 4096, t = pos < 8192 ? pos : pos - 8192;
            float z = 0.f;
            if (lane == 0) z = (float)t / (float)(L - 1);
            else if (lane <= 32) { const int jb = (lane - 1) & 15; const double frq = 1e-4 + (double)jb * ((15.0 - 1e-4) / 15.0); double r = (double)t * frq / (double)L; r -= floor(r); const float rf = (float)r;
                z = lane <= 16 ? __builtin_amdgcn_cosf(rf) : -__builtin_amdgcn_sinf(rf); }
            float a1 = a.in[8][lane];
            for (int e = 0; e < 33; ++e) a1 += xshfl(z, e) * a.in[7][e * 64 + lane];
            const float h1 = sin_rad(a.in[9][lane] * a1);
            float a2 = a.in[11][lane];
            for (int j = 0; j < 64; ++j) a2 += xshfl(h1, j) * a.in[10][j * 64 + lane];
            HID[(size_t)pos * 64 + lane] = sin_rad(a.in[12][lane] * a2);
        }
#ifdef REP_P0
        __syncthreads(); }
#endif
    }
    grid.sync();

    {
        PHASE_IDS;
        pg8::Gemm g{R1, W1T, 1024, 256, 0, 4, 1, 128};
        pg8::StaticOrder S; S.init(MTOK / 256, NP1 / 256, G, (int)blockIdx.x);
        pg8::EpiG1 E{HX, QKVO};
#ifdef REP_G1
        pg8::gemm_phase<pg8::EpiG1, pg8::StaticOrder, true, true>(lds, g, S, E); GSYNC();
#endif
        pg8::gemm_phase<pg8::EpiG1, pg8::StaticOrder, true, true>(lds, g, S, E);
        __syncthreads();
        for (int it = blockIdx.x; it < 768; it += G) taps_item(lds, it, HID, a.in[13], outb);
    }
    GSYNC();

    {
        PHASE_IDS;
        float cw0[16], cw1[16], cw2[16], cbb[16];
#pragma unroll
        for (int e = 0; e < 16; ++e) { const int col = 1536 + 16 * lane + e; cw0[e] = a.in[4][col]; cw1[e] = a.in[4][2560 + col]; cw2[e] = a.in[4][2 * 2560 + col]; cbb[e] = a.in[5][col]; }
        const float ksc = lane >= 32 ? 0.08838834764831845f : 1.0f;
        constexpr int RUN = 48;
        for (int t0 = gw * RUN; t0 < MTOK; t0 += NGW * RUN) {
            u32x4 pv[2], cv[2], nv[2];
            { const bf16_t* p = QKVO + (size_t)(t0 > 0 ? t0 - 1 : 0) * 2048 + 16 * lane; pv[0] = *(const u32x4*)p; pv[1] = *(const u32x4*)(p + 8); }
            { const bf16_t* p = QKVO + (size_t)t0 * 2048 + 16 * lane; cv[0] = *(const u32x4*)p; cv[1] = *(const u32x4*)(p + 8); }
            for (int i = 0; i < RUN; ++i) {
                const int t = t0 + i;
                { const bf16_t* p = QKVO + (size_t)(t + 1 < MTOK ? t + 1 : t) * 2048 + 16 * lane; nv[0] = *(const u32x4*)p; nv[1] = *(const u32x4*)(p + 8); }
                const float mp = pg8::seq_start(t) ? 0.f : 1.f, mn = pg8::seq_start(t + 1) ? 0.f : 1.f;
                u32x4 o[2];
#pragma unroll
                for (int h = 0; h < 2; ++h)
#pragma unroll
                    for (int e = 0; e < 4; ++e) {
                        const int d0 = 8 * h + 2 * e;
                        const float c0 = mp * cw0[d0] * bflo(pv[h][e]) + cw1[d0] * bflo(cv[h][e]) + mn * cw2[d0] * bflo(nv[h][e]) + cbb[d0];
                        const float c1 = mp * cw0[d0 + 1] * bfhi(pv[h][e]) + cw1[d0 + 1] * bfhi(cv[h][e]) + mn * cw2[d0 + 1] * bfhi(nv[h][e]) + cbb[d0 + 1];
                        o[h][e] = pk2(c0 * fsigmoid(c0) * ksc, c1 * fsigmoid(c1) * ksc);
                    }
                bf16_t* dst = R1 + (size_t)t * 1024 + 16 * lane;
                *(u32x4*)dst = o[0]; *(u32x4*)(dst + 8) = o[1];
                pv[0] = cv[0]; pv[1] = cv[1]; cv[0] = nv[0]; cv[1] = nv[1];
            }
        }
    }
    { __syncthreads(); for (int it = blockIdx.x; it < 2048; it += G) spectrum_item(lds, it, a.in[14], outb); }
    GSYNC();

#if defined(EXP_MLSTM)
    { for (int it = blockIdx.x; it < 192; it += G) { __syncthreads(); mlstm_item(lds, it, QKVO, R1, GATES, outb); } }
    GSYNC();
#endif
#if defined(EXP_HYENA)
    { for (int it = blockIdx.x; it < HY_ITEMS; it += G) { __syncthreads(); hyena_item(lds, it, HX, YH, a.in[4], a.in[5], outb); } }
    GSYNC();
#endif
    {
        PHASE_IDS;
        LAS int* slot = (LAS int*)(lds + LDS_BYTES - 16);
        for (;;) {
            LBAR();
            if (tid == 0) *slot = (int)atomicAdd(ctl, 1u);
            LBAR();
            const int item = *slot;
            if (item >= 192 + HY_ITEMS) break;
            if (item < 192) mlstm_item(lds, item, QKVO, R1, GATES, outb);
            else hyena_item(lds, item - 192, HX, YH, a.in[4], a.in[5], outb);
        }
    }
    GSYNC();

#ifdef REP_P2
    if (blockIdx.x == 0 && opaque_tid() == 0) ((unsigned*)(ws + WS_CTL))[0] = 0u;
    GSYNC();
    {
        const int tid = opaque_tid();
        LAS int* slot = (LAS int*)(lds + LDS_BYTES - 16);
        for (;;) {
            __syncthreads();
            if (tid == 0) *slot = (int)atomicAdd((unsigned*)(ws + WS_CTL), 1u);
            __syncthreads();
            const int item = *slot;
            if (item >= 192 + HY_ITEMS) break;
            if (item < 192) mlstm_item(lds, item, QKVO, R1, GATES, outb);
            else hyena_item(lds, item - 192, HX, YH, a.in[4], a.in[5], outb);
        }
    }
    GSYNC();
#endif
#ifdef REP_SYNC
    for (int i_ = 0; i_ < 10; ++i_) GSYNC();
#endif
    {
        PHASE_IDS;
        const bf16_t* YV = YH;
        const bf16_t* HF = (const bf16_t*)(outb + OUT_HF); const bf16_t* HB = (const bf16_t*)(outb + OUT_HB);
        LAS bf16_t* tl = (LAS bf16_t*)lds;
        u32x4 n0 = (u32x4){0u, 0u, 0u, 0u}, n1 = n0;
#define P2C_SRC(it_) ({ const int tt_ = (it_) >> 3, cb_ = (it_) & 7, tok_ = tt_ * 128; size_t sb_; int S_, s0_; \
            if (tok_ < MPR) { S_ = 8192; s0_ = tok_ & 8191; sb_ = (size_t)(tok_ >> 13) * 512 * 8192; } else { S_ = 4096; const int t2_ = tok_ - MPR; s0_ = t2_ & 4095; sb_ = (size_t)MPR * 512 + (size_t)(t2_ >> 12) * 512 * 4096; } \
            YV + sb_ + (size_t)(cb_ * 64 + (tid >> 3)) * S_ + s0_ + 16 * (tid & 7); })
        if ((int)blockIdx.x < 768 * 8) { const bf16_t* sp = P2C_SRC((int)blockIdx.x); n0 = *(const u32x4*)sp; n1 = *(const u32x4*)(sp + 8); }
        for (int it = blockIdx.x; it < 768 * 8; it += G) {
            const int tt = it >> 3, cb = it & 7, tok0 = tt * 128;
            const u32x4 r0 = n0, r1 = n1;
            if (it + G < 768 * 8) { const bf16_t* sp = P2C_SRC(it + G); n0 = *(const u32x4*)sp; n1 = *(const u32x4*)(sp + 8); }
            LBAR();
            { const int chl = tid >> 3, seg = tid & 7;
              *(LAS u32x4*)(tl + chl * 136 + 16 * seg) = r0; *(LAS u32x4*)(tl + chl * 136 + 16 * seg + 8) = r1; }
            LBAR();
            { const int tk = tid >> 2, cgp = tid & 3; unsigned w[8];
#pragma unroll
              for (int e = 0; e < 8; ++e) { const unsigned lo = tl[(16 * cgp + 2 * e) * 136 + tk], hi = tl[(16 * cgp + 2 * e + 1) * 136 + tk]; w[e] = lo | (hi << 16); }
              bf16_t* dst = R1 + (size_t)(tok0 + tk) * DM + cb * 64 + 16 * cgp;
              u32x4 o0, o1; o0.x = w[0]; o0.y = w[1]; o0.z = w[2]; o0.w = w[3]; o1.x = w[4]; o1.y = w[5]; o1.z = w[6]; o1.w = w[7];
              *(u32x4*)dst = o0; *(u32x4*)(dst + 8) = o1; }
        }
#undef P2C_SRC
        f32x4 mg0 = ((const f32x4*)a.in[15])[2 * lane], mg1 = ((const f32x4*)a.in[15])[2 * lane + 1];
        u32x4 nf, nb, no;
        if (gw < MTOK) { nf = *(const u32x4*)(HF + (size_t)gw * 512 + 8 * lane); nb = *(const u32x4*)(HB + (size_t)gw * 512 + 8 * lane); no = *(const u32x4*)(QKVO + (size_t)gw * 2048 + 1536 + 8 * lane); }
        for (int m = gw; m < MTOK; m += NGW) {
            const u32x4 f = nf, b = nb, o = no;
            if (m + NGW < MTOK) { const size_t m2 = (size_t)(m + NGW); nf = *(const u32x4*)(HF + m2 * 512 + 8 * lane); nb = *(const u32x4*)(HB + m2 * 512 + 8 * lane); no = *(const u32x4*)(QKVO + m2 * 2048 + 1536 + 8 * lane); }
            float h[8]; float ss = 0.f;
#pragma unroll
            for (int e = 0; e < 4; ++e) { h[2 * e] = bflo(f[e]) + bflo(b[e]); h[2 * e + 1] = bfhi(f[e]) + bfhi(b[e]); ss += h[2 * e] * h[2 * e] + h[2 * e + 1] * h[2 * e + 1]; }
            ss += xshfl_xor(ss, 1); ss += xshfl_xor(ss, 2); ss += xshfl_xor(ss, 4); ss += xshfl_xor(ss, 8);
            const float rs = rsqrtf(ss * (1.f / 128.f) + 1e-6f);
            float y[8];
#pragma unroll
            for (int e = 0; e < 4; ++e) { y[2 * e] = h[2 * e] * rs * (e < 2 ? mg0[2 * e] : mg1[2 * e - 4]) * bflo(o[e]); y[2 * e + 1] = h[2 * e + 1] * rs * (e < 2 ? mg0[2 * e + 1] : mg1[2 * e - 3]) * bfhi(o[e]); }
            u32x4 w; w.x = pk2(y[0], y[1]); w.y = pk2(y[2], y[3]); w.z = pk2(y[4], y[5]); w.w = pk2(y[6], y[7]);
            *(u32x4*)(R1 + (size_t)m * DM + 512 + 8 * lane) = w;
        }
    }
    GSYNC();

    {
        PHASE_IDS;
        pg8::Gemm g{R1, W2T, 1024, 256, 0, 128, 0, 0};
        pg8::StaticOrder S; S.init(MTOK / 256, 4, G, (int)blockIdx.x);
        pg8::EpiG2 E{xp, xs, a.out, a.in[17], H2U, SS};
#ifdef REP_G2
        pg8::gemm_phase<pg8::EpiG2, pg8::StaticOrder, true, true>(lds, g, S, E); GSYNC();
#endif
        pg8::gemm_phase<pg8::EpiG2, pg8::StaticOrder, true, true>(lds, g, S, E);
    }
    GSYNC();

    {
        PHASE_IDS;
        pg8::Gemm g{H2U, W3T, 1024, 252, -1, 4, 1, 126};
        pg8::StaticOrder S; S.init(391, 22, G, (int)blockIdx.x);
        pg8::EpiG3 E{a.in[19], a.in[20], ACT, SS};
#ifdef REP_G3
        pg8::gemm_phase<pg8::EpiG3, pg8::StaticOrder, true, true>(lds, g, S, E); GSYNC();
#endif
        pg8::gemm_phase<pg8::EpiG3, pg8::StaticOrder, true, true>(lds, g, S, E);
    }
    GSYNC();

    {
        PHASE_IDS;
        pg8::Gemm g{ACT, W4T, FF, 256, 0, 128, 0, 0};
        pg8::StaticOrder S; S.init(MTOK / 256, 4, G, (int)blockIdx.x);
        pg8::EpiG4 E{a.out, R1, SS2};
        pg8::gemm_phase<pg8::EpiG4, pg8::StaticOrder, true, true>(lds, g, S, E);
    }
    GSYNC();

    {
        PHASE_IDS;
        f32x4 gf[4];
#pragma unroll
        for (int j = 0; j < 4; ++j) gf[j] = ((const f32x4*)a.in[22])[lane + 64 * j];
        unsigned long long nx[4]; float nss = 0.f;
        if (gw < MTOK) {
#pragma unroll
            for (int j = 0; j < 4; ++j) nx[j] = ((const unsigned long long*)(R1 + (size_t)gw * DM))[lane + 64 * j];
            nss = SS2[gw];
        }
        for (int m = gw; m < MTOK; m += NGW) {
            unsigned long long v[4];
#pragma unroll
            for (int j = 0; j < 4; ++j) v[j] = nx[j];
            const float rs = rsqrtf(nss * (1.f / DM) + 1e-6f);
            if (m + NGW < MTOK) {
#pragma unroll
                for (int j = 0; j < 4; ++j) nx[j] = ((const unsigned long long*)(R1 + (size_t)(m + NGW) * DM))[lane + 64 * j];
                nss = SS2[m + NGW];
            }
            float* xrow = a.out + (size_t)m * DM;
#pragma unroll
            for (int j = 0; j < 4; ++j) {
                const unsigned lo = (unsigned)v[j], hi = (unsigned)(v[j] >> 32);
                f32x4 o; o.x = bflo(lo); o.y = bfhi(lo); o.z = bflo(hi); o.w = bfhi(hi);
                ((f32x4*)xrow)[lane + 64 * j] = o * rs * gf[j];
            }
        }
    }
}

extern "C" void kernel_launch(void* const* d_in, const int* in_sizes, int n_in, void* d_out, int out_size, void* d_ws, size_t ws_size, hipStream_t stream) {
    static int grid = 0;
    if (grid == 0) {
        int dev = 0, cus = 0, per_cu = 0;
        (void)hipGetDevice(&dev);
        (void)hipDeviceGetAttribute(&cus, hipDeviceAttributeMultiprocessorCount, dev);
        (void)hipFuncSetAttribute((const void*)fwd_kernel, hipFuncAttributeMaxDynamicSharedMemorySize, LDS_BYTES);
        (void)hipOccupancyMaxActiveBlocksPerMultiprocessor(&per_cu, (const void*)fwd_kernel, 512, LDS_BYTES);
        (void)hipGetLastError();
        grid = cus > 0 ? cus : 256;
        if (n_in != 23 || ws_size < WS_END) fprintf(stderr, "kernel_launch: unexpected n_in %d / ws %zu\n", n_in, ws_size);
    }
    (void)hipMemsetAsync((char*)d_ws + WS_BAR, 0, 16384, stream);
    Args a{};
    for (int i = 0; i < 23; ++i) a.in[i] = (const float*)d_in[i];
    a.out = (float*)d_out; a.ws = (unsigned char*)d_ws;
    void* args[] = {&a};
    hipError_t e = hipLaunchCooperativeKernel((void*)fwd_kernel, dim3(grid), dim3(512), args, LDS_BYTES, stream);
    if (e != hipSuccess) fprintf(stderr, "cooperative launch failed: %s (grid %d)\n", hipGetErrorString(e), grid);
}
```

```cpp
#include <hip/hip_runtime.h>
#include <hip/hip_cooperative_groups.h>
#include <cstdio>
#include <cstdint>
namespace cg = cooperative_groups;

#define LAS __attribute__((address_space(3)))
typedef unsigned short bf16_t;
typedef short bf16x8 __attribute__((ext_vector_type(8)));
typedef short bf16x4 __attribute__((ext_vector_type(4)));
typedef float f32x4 __attribute__((ext_vector_type(4)));
typedef float f32x2 __attribute__((ext_vector_type(2)));
typedef unsigned u32x4 __attribute__((ext_vector_type(4)));
typedef unsigned u32x2 __attribute__((ext_vector_type(2)));

constexpr int MTOK = 98304, MPR = 32768, DM = 1024, NP1 = 3584, PIN = 3600, FF = 2816, FF2 = 5632;
constexpr size_t MiB = 1u << 20;
constexpr size_t HXN = (size_t)MTOK * 512;
constexpr size_t WS_CTL = 0;
constexpr size_t WS_W1T = 1 * MiB;
constexpr size_t WS_W2T = 8 * MiB;
constexpr size_t WS_W3T = 10 * MiB;
constexpr size_t WS_W4T = 21 * MiB;
constexpr size_t WS_HID = 27 * MiB;
constexpr size_t WS_GATES = 30 * MiB;
constexpr size_t WS_R1 = 36 * MiB;
constexpr size_t R1_PAD_ROWS = 256;
constexpr size_t WS_HX = 232 * MiB;
constexpr size_t WS_QKVO = 520 * MiB;
constexpr size_t WS_ACT = WS_HX;
constexpr size_t WS_YH = 904 * MiB;
constexpr size_t WS_H2U = 761 * MiB;
constexpr size_t WS_BAR = 512 * 1024;
constexpr size_t WS_SS = 4096;
constexpr size_t WS_END = 1000 * MiB;
static_assert(WS_H2U >= WS_ACT + (size_t)MTOK * FF * 2 + 2048 && WS_H2U + (size_t)(MTOK + 1024) * 2048 <= WS_END, "ws map");
static_assert(WS_R1 + (R1_PAD_ROWS + MTOK + 1024) * 2048 <= WS_HX, "ws map");
static_assert(WS_ACT + (size_t)MTOK * FF * 2 <= WS_YH, "ws map");
constexpr size_t OUT_SPEC0 = 0;
constexpr size_t OUT_SPEC1 = 128 * MiB;
constexpr size_t OUT_HF = 192 * MiB;
constexpr size_t OUT_HB = 288 * MiB;
constexpr size_t OUT_TAPS = OUT_HF;

constexpr int LDS_BYTES = 150528;

__device__ __forceinline__ unsigned pk2(float lo, float hi) { unsigned r; asm("v_cvt_pk_bf16_f32 %0, %1, %2" : "=v"(r) : "v"(lo), "v"(hi)); return r; }
__device__ __forceinline__ unsigned f2bf(float f) { return pk2(f, f) & 0xffffu; }
__device__ __forceinline__ float bflo(unsigned w) { return __builtin_bit_cast(float, w << 16); }
__device__ __forceinline__ float bfhi(unsigned w) { return __builtin_bit_cast(float, w & 0xffff0000u); }
__device__ __forceinline__ float bf1(bf16_t b) { return __builtin_bit_cast(float, ((unsigned)b) << 16); }
__device__ __forceinline__ int opaque_tid() { int t = (int)__builtin_amdgcn_workitem_id_x(); asm volatile("" : "+v"(t)); return t; }
__device__ __forceinline__ float xshfl(float v, int src) { return __builtin_bit_cast(float, __builtin_amdgcn_ds_bpermute(src << 2, __builtin_bit_cast(int, v))); }
__device__ __forceinline__ float xshfl_xor(float v, int m) { return xshfl(v, (opaque_tid() & 63) ^ m); }
__device__ __forceinline__ float wave_sum(float v) {
#pragma unroll
    for (int o = 1; o < 64; o <<= 1) v += xshfl_xor(v, o);
    return v;
}
__device__ __forceinline__ float fsigmoid(float x) { return __builtin_amdgcn_rcpf(1.f + __expf(-x)); }
__device__ __forceinline__ float sin_rad(float y) { return __builtin_amdgcn_sinf(__builtin_amdgcn_fractf(y * 0.15915494309189535f)); }
#define LDS_WAIT() asm volatile("s_waitcnt lgkmcnt(0)" ::: "memory")
#define LBAR() do { asm volatile("s_waitcnt lgkmcnt(0)" ::: "memory"); __builtin_amdgcn_s_barrier(); asm volatile("" ::: "memory"); } while (0)

namespace pg8 {
#define PG8_LAS __attribute__((address_space(3)))
constexpr int BM = 256, BK = 64, HALF = 128, HTB = HALF * BK * 2, STAGE_BYTES = 8 * HTB, NXCD = 8, WGM = 8;
__host__ __device__ __forceinline__ int lds_byte(int r, int c) { const int st = (r >> 4) * 2 + (c >> 5), rr = r & 15, cc = c & 31, ob = rr * 64 + cc * 2; return st * 1024 + (ob ^ (((ob >> 9) & 1) << 5)); }
__host__ __device__ __forceinline__ void stage_rc(int b, int& R, int& C) { const int st = b / 1024, sb = b % 1024, swz = sb ^ (((sb >> 9) & 1) << 5); R = (st >> 1) * 16 + swz / 64; C = (st & 1) * 32 + (swz % 64) / 2; }
__host__ __device__ __forceinline__ int perm32(int rho) { const int n = rho >> 4, i = rho & 15; return 8 * (i >> 2) + 4 * n + (i & 3); }
struct Unit { int pm, pn; };
struct Gemm { const bf16_t* A; const bf16_t* Bt; int K; int a_tile_rows; int a_row0; int a_half_rows; int amode; int span; };
struct StaticOrder {
    int nM, nN, nwg, G, c;
    __host__ __device__ void init(int nM_, int nN_, int G_, int c_) { nM = nM_; nN = nN_; nwg = nM * nN; G = G_; c = c_; }
    __host__ __device__ bool next(int i, Unit& u) const {
        const long L = (long)i * G + c; if (L >= nwg) return false;
        int wgid = (int)L; { const int q = nwg / NXCD, r = nwg % NXCD, xcd = wgid % NXCD, off = wgid / NXCD; wgid = (xcd < r ? xcd * (q + 1) : r * (q + 1) + (xcd - r) * q) + off; }
        const int nig = WGM * nN, gid = wgid / nig, fm = gid * WGM, gsz = (nM - fm) < WGM ? (nM - fm) : WGM;
        u.pm = fm + ((wgid % nig) % gsz); u.pn = (wgid % nig) / gsz; return true;
    }
};
__device__ __forceinline__ unsigned cvt_pk_bf16(float lo, float hi) { unsigned r; asm volatile("v_cvt_pk_bf16_f32 %0, %1, %2" : "=v"(r) : "v"(lo), "v"(hi)); return r; }

template <class Epi, class Sched, bool ALIGN_EPI = false, bool SP2 = false>
__device__ __forceinline__ void gemm_phase(PG8_LAS unsigned char* lds, const Gemm g, const Sched& S, const Epi& E) {
    const int tid = opaque_tid(), wid = __builtin_amdgcn_readfirstlane(tid >> 6), lane = tid & 63, wr = wid >> 2, wc = wid & 3, fr = lane & 15, fq = lane >> 4;
    const int K = g.K, nt = K / BK;
    unsigned voffA[2], voffB[2];
#pragma unroll
    for (int i = 0; i < 2; ++i) { int R, C; stage_rc(tid * 16 + i * 8192, R, C); const int Rb = Epi::PERM ? ((R & ~31) + perm32(R & 31)) : R;
        const int Ra = g.amode ? (g.span * (R >> 6) + 8 * (R & 15) + ((R >> 4) & 3)) : R;
        voffA[i] = (unsigned)(Ra * K + C) * 2u; voffB[i] = (unsigned)(Rb * K + C) * 2u; }
    const size_t kstep = (size_t)(BK * 2);
    const size_t hstepB = (size_t)HALF * K * 2;
    const size_t hstepA = (size_t)g.a_half_rows * K * 2;
    const size_t tstepB = 2 * hstepB;
    const unsigned ldsw = (unsigned)wid * 1024u;
    const int aoff = lds_byte(wr * 64 + fr, fq * 8), boff = lds_byte(wc * 32 + fr, fq * 8);
#define PG8_ABASE(pm) ((const char*)g.A + ((long)(pm) * g.a_tile_rows + g.a_row0) * (long)K * 2)
#define PG8_SA(b, h) (((b) * 2 + (h)) * HTB)
#define PG8_SB(b, h) ((4 + (b) * 2 + (h)) * HTB)
#define PG8_STAGE(bufoff, gbase, voff) do { _Pragma("unroll") for (int _i = 0; _i < 2; ++_i) \
        __builtin_amdgcn_global_load_lds((const unsigned*)((const char*)(gbase) + (voff)[_i]), (PG8_LAS unsigned*)(lds + (bufoff) + ldsw + _i * 8192), 16, 0, 0); } while (0)
#define PG8_LDA(dst, b, h) do { _Pragma("unroll") for (int m = 0; m < 4; ++m) _Pragma("unroll") for (int k = 0; k < 2; ++k) dst[m][k] = *(const PG8_LAS bf16x8*)(lds + PG8_SA(b, h) + aoff + m * 2048 + k * 1024); } while (0)
#define PG8_LDB(dst, b, h) do { _Pragma("unroll") for (int n = 0; n < 2; ++n) _Pragma("unroll") for (int k = 0; k < 2; ++k) dst[n][k] = *(const PG8_LAS bf16x8*)(lds + PG8_SB(b, h) + boff + n * 2048 + k * 1024); } while (0)
#define PG8_MMA(ai, bj, At, Bt) do { __builtin_amdgcn_s_setprio(1); _Pragma("unroll") for (int m = 0; m < 4; ++m) _Pragma("unroll") for (int n = 0; n < 2; ++n) _Pragma("unroll") for (int k = 0; k < 2; ++k) \
        acc[ai][bj][m][n] = __builtin_amdgcn_mfma_f32_16x16x32_bf16(Bt[n][k], At[m][k], acc[ai][bj][m][n], 0, 0, 0); __builtin_amdgcn_s_setprio(0); } while (0)
#define PG8_WAIT_V(n) asm volatile("s_waitcnt vmcnt(" #n ")" ::: "memory")
#define PG8_WAIT_L(n) asm volatile("s_waitcnt lgkmcnt(" #n ")" ::: "memory")
#define PG8_BAR __builtin_amdgcn_s_barrier()
#define PG8_SCHED __builtin_amdgcn_sched_barrier(0)
    Unit cur, nxt; int ui = 0;
    if (!S.next(0, cur)) return;
    f32x4 acc[2][2][4][2];
#pragma unroll
    for (int a = 0; a < 2; ++a)
#pragma unroll
        for (int b = 0; b < 2; ++b)
#pragma unroll
            for (int m = 0; m < 4; ++m)
#pragma unroll
                for (int n = 0; n < 2; ++n) acc[a][b][m][n] = (f32x4){0.f, 0.f, 0.f, 0.f};
    bf16x8 At[4][2], B0[2][2], B1[2][2];
    const char* cA = PG8_ABASE(cur.pm); const char* cB = (const char*)g.Bt + (size_t)cur.pn * tstepB;
    if constexpr (SP2) {
        PG8_STAGE(PG8_SB(0, 0), cB, voffB); PG8_STAGE(PG8_SB(0, 1), cB + hstepB, voffB); PG8_STAGE(PG8_SA(0, 0), cA, voffA); PG8_STAGE(PG8_SA(0, 1), cA + hstepA, voffA);
        if (wr == 1) PG8_BAR;
        PG8_WAIT_V(2); PG8_BAR;
        PG8_STAGE(PG8_SB(1, 0), cB + kstep, voffB); PG8_STAGE(PG8_SA(1, 0), cA + kstep, voffA); PG8_STAGE(PG8_SB(1, 1), cB + hstepB + kstep, voffB);
        PG8_WAIT_V(6); PG8_BAR;
    } else {
        PG8_STAGE(PG8_SB(0, 0), cB, voffB); PG8_STAGE(PG8_SA(0, 0), cA, voffA); PG8_STAGE(PG8_SB(0, 1), cB + hstepB, voffB); PG8_STAGE(PG8_SA(0, 1), cA + hstepA, voffA);
        if (wr == 1) PG8_BAR;
        PG8_WAIT_V(4); PG8_BAR;
        PG8_STAGE(PG8_SB(1, 0), cB + kstep, voffB); PG8_STAGE(PG8_SA(1, 0), cA + kstep, voffA); PG8_STAGE(PG8_SB(1, 1), cB + hstepB + kstep, voffB);
        PG8_WAIT_V(6); PG8_BAR;
    }
    for (;;) {
        const bool has_next = S.next(ui + 1, nxt);
        const char* nA = has_next ? PG8_ABASE(nxt.pm) : cA; const char* nB = has_next ? (const char*)g.Bt + (size_t)nxt.pn * tstepB : cB;
        for (int t = 0; t < nt; t += 2) {
            const bool last = (t == nt - 2);
            const char* a1 = cA + (size_t)(t + 1) * kstep;
            const char* a2 = last ? nA : cA + (size_t)(t + 2) * kstep; const char* b2 = last ? nB : cB + (size_t)(t + 2) * kstep;
            const char* a3 = a2 + kstep; const char* b3 = b2 + kstep;
            if constexpr (SP2) {
            PG8_LDB(B0, 0, 0); PG8_LDB(B1, 0, 1); PG8_SCHED; PG8_LDA(At, 0, 0); PG8_STAGE(PG8_SA(1, 1), a1 + hstepA, voffA);
            PG8_WAIT_V(8); PG8_WAIT_L(0); PG8_BAR; PG8_MMA(0, 0, At, B0); PG8_MMA(0, 1, At, B1); PG8_BAR; PG8_SCHED;
            PG8_LDA(At, 0, 1); PG8_STAGE(PG8_SB(0, 0), b2, voffB); PG8_STAGE(PG8_SB(0, 1), b2 + hstepB, voffB); PG8_STAGE(PG8_SA(0, 0), a2, voffA);
            PG8_WAIT_V(8); PG8_WAIT_L(0); PG8_BAR; PG8_MMA(1, 0, At, B0); PG8_MMA(1, 1, At, B1); PG8_BAR; PG8_SCHED;
            PG8_LDB(B0, 1, 0); PG8_LDB(B1, 1, 1); PG8_SCHED; PG8_LDA(At, 1, 0); PG8_STAGE(PG8_SA(0, 1), a2 + hstepA, voffA);
            PG8_WAIT_V(8); PG8_WAIT_L(0); PG8_BAR; PG8_MMA(0, 0, At, B0); PG8_MMA(0, 1, At, B1); PG8_BAR; PG8_SCHED;
            PG8_LDA(At, 1, 1); PG8_STAGE(PG8_SB(1, 0), b3, voffB); PG8_STAGE(PG8_SB(1, 1), b3 + hstepB, voffB); PG8_STAGE(PG8_SA(1, 0), a3, voffA);
            PG8_WAIT_V(8); PG8_WAIT_L(0); PG8_BAR; PG8_MMA(1, 0, At, B0); PG8_MMA(1, 1, At, B1); PG8_BAR; PG8_SCHED;
            } else {
            PG8_LDB(B0, 0, 0); PG8_SCHED; PG8_LDA(At, 0, 0); PG8_STAGE(PG8_SA(1, 1), a1 + hstepA, voffA);
            PG8_WAIT_L(8); PG8_BAR; PG8_WAIT_L(0); PG8_MMA(0, 0, At, B0); PG8_BAR; PG8_SCHED;
            PG8_LDB(B1, 0, 1); PG8_STAGE(PG8_SB(0, 0), b2, voffB);
            PG8_BAR; PG8_WAIT_L(0); PG8_MMA(0, 1, At, B1); PG8_BAR;
            PG8_LDA(At, 0, 1); PG8_STAGE(PG8_SA(0, 0), a2, voffA);
            PG8_BAR; PG8_WAIT_L(0); PG8_MMA(1, 0, At, B0); PG8_BAR; PG8_SCHED;
            PG8_STAGE(PG8_SB(0, 1), b2 + hstepB, voffB);
            PG8_WAIT_V(6); PG8_BAR; PG8_MMA(1, 1, At, B1); PG8_BAR;
            PG8_LDB(B0, 1, 0); PG8_SCHED; PG8_LDA(At, 1, 0); PG8_STAGE(PG8_SA(0, 1), a2 + hstepA, voffA);
            PG8_WAIT_L(8); PG8_BAR; PG8_WAIT_L(0); PG8_MMA(0, 0, At, B0); PG8_BAR; PG8_SCHED;
            PG8_LDB(B1, 1, 1); PG8_STAGE(PG8_SB(1, 0), b3, voffB);
            PG8_BAR; PG8_WAIT_L(0); PG8_MMA(0, 1, At, B1); PG8_BAR;
            PG8_LDA(At, 1, 1); PG8_STAGE(PG8_SA(1, 0), a3, voffA);
            PG8_BAR; PG8_WAIT_L(0); PG8_MMA(1, 0, At, B0); PG8_BAR; PG8_SCHED;
            PG8_STAGE(PG8_SB(1, 1), b3 + hstepB, voffB);
            PG8_WAIT_V(6); PG8_BAR; PG8_MMA(1, 1, At, B1); PG8_BAR;
            }
        }
        if constexpr (ALIGN_EPI) { if (wr == 0) PG8_BAR; }
        E(acc, cur, wr, wc, fr, fq);
        if (!has_next) break;
#pragma unroll
        for (int a = 0; a < 2; ++a)
#pragma unroll
            for (int b = 0; b < 2; ++b)
#pragma unroll
                for (int m = 0; m < 4; ++m)
#pragma unroll
                    for (int n = 0; n < 2; ++n) acc[a][b][m][n] = (f32x4){0.f, 0.f, 0.f, 0.f};
        cur = nxt; cA = nA; cB = nB; ++ui;
        if constexpr (ALIGN_EPI) { if (wr == 1) PG8_BAR; }
    }
    PG8_WAIT_V(0);
    if constexpr (!ALIGN_EPI) { if (wr == 0) PG8_BAR; }
    PG8_BAR;
#undef PG8_ABASE
#undef PG8_SA
#undef PG8_SB
#undef PG8_STAGE
#undef PG8_LDA
#undef PG8_LDB
#undef PG8_MMA
#undef PG8_WAIT_V
#undef PG8_WAIT_L
#undef PG8_BAR
#undef PG8_SCHED
}

struct EpiG1 {
    static constexpr bool PERM = true;
    bf16_t* HX; bf16_t* QKVO;
    __device__ __forceinline__ void operator()(f32x4 (&acc)[2][2][4][2], const Unit& u, int wr_, int wc_, int fr_, int fq_) const {
        const int tid_e = opaque_tid(), wid_e = __builtin_amdgcn_readfirstlane(tid_e >> 6), wr = wid_e >> 2, wc = wid_e & 3, fr = tid_e & 15, fq = (tid_e & 63) >> 4; (void)wr_; (void)wc_; (void)fr_; (void)fq_;
        const int tok0 = u.pm * 256 + wr * 128 + fr * 8;
        if (u.pn < 6) {
            bf16_t* T = HX + (size_t)(u.pn >> 1) * HXN;
            size_t sbase; int S, s;
            if (tok0 < MPR) { S = 8192; const int b = tok0 >> 13; s = tok0 & 8191; sbase = (size_t)b * 512 * 8192; }
            else { S = 4096; const int t2 = tok0 - MPR; const int b = t2 >> 12; s = t2 & 4095; sbase = (size_t)MPR * 512 + (size_t)b * 512 * 4096; }
            const int c0 = (u.pn & 1) * 256 + wc * 32 + 8 * fq;
#pragma unroll
            for (int bj = 0; bj < 2; ++bj)
#pragma unroll
                for (int n = 0; n < 2; ++n)
#pragma unroll
                    for (int e = 0; e < 4; ++e) {
                        const int c = c0 + bj * 128 + 4 * n + e;
                        u32x4 w;
                        w.x = cvt_pk_bf16(acc[0][bj][0][n][e], acc[0][bj][1][n][e]); w.y = cvt_pk_bf16(acc[0][bj][2][n][e], acc[0][bj][3][n][e]);
                        w.z = cvt_pk_bf16(acc[1][bj][0][n][e], acc[1][bj][1][n][e]); w.w = cvt_pk_bf16(acc[1][bj][2][n][e], acc[1][bj][3][n][e]);
                        *(u32x4*)(T + sbase + (size_t)c * S + s) = w;
                        if (e == 3) asm volatile("" ::: "memory");
                    }
        } else {
            const int cq0 = (u.pn - 6) * 256 + wc * 32 + 8 * fq;
            const bool sg = (u.pn >= 12);
#pragma unroll
            for (int ai = 0; ai < 2; ++ai)
#pragma unroll
                for (int m = 0; m < 4; ++m) {
                    bf16_t* rowp = QKVO + (size_t)(tok0 + ai * 4 + m) * 2048 + cq0;
#pragma unroll
                    for (int bj = 0; bj < 2; ++bj) {
                        f32x4 v0 = acc[ai][bj][m][0], v1 = acc[ai][bj][m][1];
                        if (sg) {
#pragma unroll
                            for (int e = 0; e < 4; ++e) { v0[e] = fsigmoid(v0[e]); v1[e] = fsigmoid(v1[e]); }
                        }
                        u32x4 w; w.x = cvt_pk_bf16(v0[0], v0[1]); w.y = cvt_pk_bf16(v0[2], v0[3]); w.z = cvt_pk_bf16(v1[0], v1[1]); w.w = cvt_pk_bf16(v1[2], v1[3]);
                        *(u32x4*)(rowp + bj * 128) = w;
                    }
                    asm volatile("" ::: "memory");
                }
        }
    }
};
struct EpiG2 {
    static constexpr bool PERM = true;
    const float* xp; const float* xs; float* out; const float* g2; bf16_t* H2U; float* SS;
    __device__ __forceinline__ void operator()(f32x4 (&acc)[2][2][4][2], const Unit& u, int wr_, int wc_, int fr_, int fq_) const {
        const int tid_e = opaque_tid(), wid_e = __builtin_amdgcn_readfirstlane(tid_e >> 6), wr = wid_e >> 2, wc = wid_e & 3, fr = tid_e & 15, fq = (tid_e & 63) >> 4; (void)wr_; (void)wc_; (void)fr_; (void)fq_;
        const int row0 = u.pm * 256 + wr * 64 + fr, col0 = u.pn * 256 + wc * 32 + 8 * fq;
        f32x4 gv[2][2];
#pragma unroll
        for (int bj = 0; bj < 2; ++bj)
#pragma unroll
            for (int n = 0; n < 2; ++n) gv[bj][n] = *(const f32x4*)(g2 + col0 + bj * 128 + 4 * n);
#pragma unroll
        for (int ai = 0; ai < 2; ++ai) {
            f32x4 xr4[4][2][2];
#pragma unroll
            for (int m = 0; m < 4; ++m) {
                const int row = row0 + ai * 128 + m * 16;
                const float* xr = (row < MPR ? xp + (size_t)row * DM : xs + (size_t)(row - MPR) * DM) + col0;
#pragma unroll
                for (int bj = 0; bj < 2; ++bj) { xr4[m][bj][0] = *(const f32x4*)(xr + bj * 128); xr4[m][bj][1] = *(const f32x4*)(xr + bj * 128 + 4); }
            }
#pragma unroll
            for (int m = 0; m < 4; ++m) {
                const int row = row0 + ai * 128 + m * 16;
                float* o = out + (size_t)row * DM + col0;
                bf16_t* hb = H2U + (size_t)row * DM + col0;
                float s = 0.f;
#pragma unroll
                for (int bj = 0; bj < 2; ++bj) {
                    const f32x4 v0 = xr4[m][bj][0] + acc[ai][bj][m][0], v1 = xr4[m][bj][1] + acc[ai][bj][m][1];
                    *(f32x4*)(o + bj * 128) = v0; *(f32x4*)(o + bj * 128 + 4) = v1;
                    s += (v0.x * v0.x + v0.y * v0.y) + (v0.z * v0.z + v0.w * v0.w) + (v1.x * v1.x + v1.y * v1.y) + (v1.z * v1.z + v1.w * v1.w);
                    const f32x4 h0 = v0 * gv[bj][0], h1 = v1 * gv[bj][1];
                    u32x4 w; w.x = cvt_pk_bf16(h0[0], h0[1]); w.y = cvt_pk_bf16(h0[2], h0[3]); w.z = cvt_pk_bf16(h1[0], h1[1]); w.w = cvt_pk_bf16(h1[2], h1[3]);
                    *(u32x4*)(hb + bj * 128) = w;
                }
                s += xshfl_xor(s, 16); s += xshfl_xor(s, 32);
                if (fq == 0) atomicAdd(SS + row, s);
            }
        }
    }
};
struct EpiG4 {
    static constexpr bool PERM = false;
    float* out;
    __device__ __forceinline__ void operator()(f32x4 (&acc)[2][2][4][2], const Unit& u, int wr_, int wc_, int fr_, int fq_) const {
        const int tid_e = opaque_tid(), wid_e = __builtin_amdgcn_readfirstlane(tid_e >> 6), wr = wid_e >> 2, wc = wid_e & 3, fr = tid_e & 15, fq = (tid_e & 63) >> 4; (void)wr_; (void)wc_; (void)fr_; (void)fq_;
        const int row0 = u.pm * 256 + wr * 64 + fr, col0 = u.pn * 256 + wc * 32 + 4 * fq;
#pragma unroll
        for (int ai = 0; ai < 2; ++ai) {
            f32x4 xr4[4][2][2];
#pragma unroll
            for (int m = 0; m < 4; ++m) {
                const float* o = out + (size_t)(row0 + ai * 128 + m * 16) * DM + col0;
#pragma unroll
                for (int bj = 0; bj < 2; ++bj)
#pragma unroll
                    for (int n = 0; n < 2; ++n) xr4[m][bj][n] = *(const f32x4*)(o + bj * 128 + n * 16);
            }
#pragma unroll
            for (int m = 0; m < 4; ++m) {
                float* o = out + (size_t)(row0 + ai * 128 + m * 16) * DM + col0;
#pragma unroll
                for (int bj = 0; bj < 2; ++bj)
#pragma unroll
                    for (int n = 0; n < 2; ++n) *(f32x4*)(o + bj * 128 + n * 16) = xr4[m][bj][n] + acc[ai][bj][m][n];
            }
        }
    }
};
__device__ __forceinline__ float dpp_row_shr1(float x) { return __builtin_bit_cast(float, __builtin_amdgcn_update_dpp(0, __builtin_bit_cast(int, x), 0x111, 0xf, 0xf, false)); }
__device__ __forceinline__ float dpp_row_shl1(float x) { return __builtin_bit_cast(float, __builtin_amdgcn_update_dpp(0, __builtin_bit_cast(int, x), 0x101, 0xf, 0xf, false)); }
__device__ __forceinline__ bool seq_start(int g) { return g < MPR ? ((g & 8191) == 0) : ((g & 4095) == 0); }
struct EpiG3 {
    static constexpr bool PERM = true;
    const float* cw; const float* cb; bf16_t* ACT; const float* SS;
    __device__ __forceinline__ void operator()(f32x4 (&acc)[2][2][4][2], const Unit& u, int wr_, int wc_, int fr_, int fq_) const {
        const int tid_e = opaque_tid(), wid_e = __builtin_amdgcn_readfirstlane(tid_e >> 6), wr = wid_e >> 2, wc = wid_e & 3, fr = tid_e & 15, fq = (tid_e & 63) >> 4; (void)wr_; (void)wc_; (void)fr_; (void)fq_;
        const int gbase = u.pm * 252 + wr * 126 + 8 * fr - 1;
        const int ch0 = u.pn * 128 + wc * 32 + 8 * fq;
        {
            const float* sp = SS + gbase;
            float rs[8];
#pragma unroll
            for (int i = 0; i < 8; ++i) rs[i] = sp[i];
#pragma unroll
            for (int i = 0; i < 8; ++i) {
                const float r = rsqrtf(rs[i] * (1.f / DM) + 1e-6f);
#pragma unroll
                for (int bj = 0; bj < 2; ++bj)
#pragma unroll
                    for (int n = 0; n < 2; ++n) acc[i >> 2][bj][i & 3][n] = acc[i >> 2][bj][i & 3][n] * r;
            }
            asm volatile("" ::: "memory");
        }
        f32x4 WV[2][4], WG[2][4];
#pragma unroll
        for (int n = 0; n < 2; ++n) {
#pragma unroll
            for (int r = 0; r < 3; ++r) { WV[n][r] = *(const f32x4*)(cw + r * FF2 + ch0 + 4 * n); WG[n][r] = *(const f32x4*)(cw + r * FF2 + FF + ch0 + 4 * n); }
            WV[n][3] = *(const f32x4*)(cb + ch0 + 4 * n); WG[n][3] = *(const f32x4*)(cb + FF + ch0 + 4 * n);
        }
        float dep = 0.f;
#pragma unroll
        for (int n = 0; n < 2; ++n)
#pragma unroll
            for (int e = 0; e < 4; ++e) {
                const float wv0 = WV[n][0][e], wv1 = WV[n][1][e], wv2 = WV[n][2][e], bv = WV[n][3][e];
                const float wg0 = WG[n][0][e], wg1 = WG[n][1][e], wg2 = WG[n][2][e], bg = WG[n][3][e];
                float s0 = acc[1][0][3][n][e], s1 = acc[0][0][0][n][e], s2 = acc[1][1][3][n][e], s3 = acc[0][1][0][n][e];
                asm volatile("" : "+v"(s0), "+v"(s1), "+v"(s2), "+v"(s3) : "v"(dep));
                const float Vp = dpp_row_shr1(s0), Vn = dpp_row_shl1(s1), Gp = dpp_row_shr1(s2), Gn = dpp_row_shl1(s3);
                float pv = Vp, pg = Gp;
#pragma unroll
                for (int i = 0; i < 8; ++i) {
                    const float cvv = acc[i >> 2][0][i & 3][n][e], cgg = acc[i >> 2][1][i & 3][n][e];
                    const float nv = (i == 7) ? Vn : acc[(i + 1 > 7 ? 7 : i + 1) >> 2][0][(i + 1 > 7 ? 7 : i + 1) & 3][n][e];
                    const float ng = (i == 7) ? Gn : acc[(i + 1 > 7 ? 7 : i + 1) >> 2][1][(i + 1 > 7 ? 7 : i + 1) & 3][n][e];
                    const bool sti = seq_start(gbase + i), eni = seq_start(gbase + i + 1);
                    const float cv = wv1 * cvv + bv + (sti ? 0.f : wv0 * pv) + (eni ? 0.f : wv2 * nv);
                    const float cgt = wg1 * cgg + bg + (sti ? 0.f : wg0 * pg) + (eni ? 0.f : wg2 * ng);
                    acc[i >> 2][0][i & 3][n][e] = cv * cgt * fsigmoid(cgt);
                    pv = cvv; pg = cgg;
                }
                dep = acc[1][0][3][n][e];
            }
#pragma unroll
        for (int i = 0; i < 8; ++i) {
            const int li = 8 * fr + i, g = gbase + i;
            if (li >= 1 && li <= 126 && g < MTOK) {
                const f32x4 v0 = acc[i >> 2][0][i & 3][0], v1 = acc[i >> 2][0][i & 3][1];
                u32x4 w; w.x = cvt_pk_bf16(v0[0], v0[1]); w.y = cvt_pk_bf16(v0[2], v0[3]); w.z = cvt_pk_bf16(v1[0], v1[1]); w.w = cvt_pk_bf16(v1[2], v1[3]);
                *(u32x4*)(ACT + (size_t)g * FF + ch0) = w;
            }
        }
    }
};
}

__device__ __forceinline__ int padidx(int p) { return p + ((p >> 6) << 2); }
template <int NN> __device__ __forceinline__ int padidxN(int p) { return NN == 8192 ? p + ((p >> 5) << 1) : p + ((p >> 6) << 2); }
__device__ __forceinline__ float cos16(int k) { switch (k & 7) { case 0: return 1.f; case 1: return 0.92387953251f; case 2: return 0.70710678119f; case 3: return 0.38268343237f; case 4: return 0.f; case 5: return -0.38268343237f; case 6: return -0.70710678119f; default: return -0.92387953251f; } }
__device__ __forceinline__ float sin16(int k) { switch (k & 7) { case 0: return 0.f; case 1: return 0.38268343237f; case 2: return 0.70710678119f; case 3: return 0.92387953251f; case 4: return 1.f; case 5: return 0.92387953251f; case 6: return 0.70710678119f; default: return 0.38268343237f; } }
template <int R> __device__ __forceinline__ constexpr int bitrev_r(int i) { int r = 0; for (int b = 1, c = R >> 1; b < R; b <<= 1, c >>= 1) if (i & b) r |= c; return r; }
typedef f32x2 cplx;
__device__ __forceinline__ cplx cmul(cplx a, cplx w) { const cplx sw = __builtin_shufflevector(a, a, 1, 0); return a * (cplx){w.x, w.x} + sw * (cplx){-w.y, w.y}; }
__device__ __forceinline__ cplx cmulc(cplx a, cplx w) { const cplx sw = __builtin_shufflevector(a, a, 1, 0); return a * (cplx){w.x, w.x} + sw * (cplx){w.y, -w.y}; }
template <int R, bool ZH> __device__ __forceinline__ void reg_fft_fwd(cplx (&x)[R]) {
#pragma unroll
    for (int half = R / 2; half >= 1; half >>= 1) {
#pragma unroll
        for (int i = 0; i < R; ++i) {
            if ((i & half) == 0) {
                const int j = i + half, k16 = (i & (half - 1)) * 8 / half;
                const cplx a = x[i], b = x[j];
                cplx d;
                if (ZH && half == R / 2) { d = a; } else { x[i] = a + b; d = a - b; }
                if (k16 == 0) x[j] = d;
                else if (k16 == 4) { cplx t; t.x = d.y; t.y = -d.x; x[j] = t; }
                else x[j] = cmulc(d, (cplx){cos16(k16), sin16(k16)});
            }
        }
    }
}
template <int R, bool OH> __device__ __forceinline__ void reg_fft_inv(cplx (&x)[R]) {
#pragma unroll
    for (int half = 1; half < R; half <<= 1) {
#pragma unroll
        for (int i = 0; i < R; ++i) {
            if ((i & half) == 0) {
                const int j = i + half, k16 = (i & (half - 1)) * 8 / half;
                const cplx a = x[i]; cplx b = x[j];
                if (k16 == 0) {}
                else if (k16 == 4) { cplx t; t.x = -b.y; t.y = b.x; b = t; }
                else b = cmul(b, (cplx){cos16(k16), sin16(k16)});
                x[i] = a + b;
                if (!(OH && half == R / 2)) x[j] = a - b;
            }
        }
    }
}
template <int R> __device__ __forceinline__ void tw_powers(cplx w1, cplx (&P)[R]) {
    P[0] = (cplx){1.f, 0.f}; P[1] = w1;
    if (R > 2) { P[2] = cmul(w1, w1); P[3] = cmul(P[2], w1); }
    if (R > 4) { P[4] = cmul(P[2], P[2]); P[5] = cmul(P[4], w1); P[6] = cmul(P[3], P[3]); P[7] = cmul(P[4], P[3]); }
    if (R > 8) { P[8] = cmul(P[4], P[4]); P[9] = cmul(P[8], w1); P[10] = cmul(P[5], P[5]); P[11] = cmul(P[8], P[3]); P[12] = cmul(P[6], P[6]); P[13] = cmul(P[8], P[5]); P[14] = cmul(P[7], P[7]); P[15] = cmul(P[8], P[7]); }
}
template <int R, bool INV, bool NOTW, bool HALF, int MBLK, int NN, int NZ = 1> __device__ __forceinline__ void fft_pass(LAS cplx* Z, const LAS cplx* TW) {
    constexpr int s = MBLK / R;
    constexpr int ZSTR = NN + NN / 16;
#define FOFF(k) (NN == 8192 ? ((k) * s + ((((k) * s) >> 5) << 1)) : ((k) * s + ((((k) * s) >> 6) << 2)))
    constexpr int TSH = 16384 / MBLK;
    for (int t = opaque_tid(); t < NN / R; t += 512) {
        const int j = t % s, b0 = (t / s) * MBLK + j;
        LAS cplx* zp = Z + padidxN<NN>(b0);
        cplx x[NZ][R]; cplx P[R];
        if (!INV) {
#pragma unroll
            for (int z = 0; z < NZ; ++z) {
#pragma unroll
                for (int k = 0; k < (HALF ? R / 2 : R); ++k) x[z][k] = zp[z * ZSTR + FOFF(k)];
                if (HALF) {
#pragma unroll
                    for (int k = R / 2; k < R; ++k) x[z][k] = (cplx){0.f, 0.f};
                }
            }
            if (!NOTW) tw_powers<R>(TW[j * TSH], P);
#pragma unroll
            for (int z = 0; z < NZ; ++z) {
                reg_fft_fwd<R, HALF>(x[z]);
#pragma unroll
                for (int i = 0; i < R; ++i) { const int q = bitrev_r<R>(i); zp[z * ZSTR + FOFF(q)] = (NOTW || q == 0) ? x[z][i] : cmulc(x[z][i], P[q]); }
            }
        } else {
#pragma unroll
            for (int z = 0; z < NZ; ++z)
#pragma unroll
                for (int i = 0; i < R; ++i) { const int q = bitrev_r<R>(i); x[z][i] = zp[z * ZSTR + FOFF(q)]; }
            if (!NOTW) tw_powers<R>(TW[j * TSH], P);
#pragma unroll
            for (int z = 0; z < NZ; ++z) {
                if (!NOTW) {
#pragma unroll
                    for (int i = 0; i < R; ++i) { const int q = bitrev_r<R>(i); if (q != 0) x[z][i] = cmul(x[z][i], P[q]); }
                }
                reg_fft_inv<R, HALF>(x[z]);
#pragma unroll
                for (int k = 0; k < (HALF ? R / 2 : R); ++k) zp[z * ZSTR + FOFF(k)] = x[z][k];
            }
        }
    }
    LBAR();
}
template <int NN> __device__ __forceinline__ void fft_fwd_full(LAS cplx* Z, const LAS cplx* TW) {
    fft_pass<16, false, false, false, NN, NN>(Z, TW); fft_pass<16, false, false, false, NN / 16, NN>(Z, TW); fft_pass<16, false, false, false, NN / 256, NN>(Z, TW);
    fft_pass<NN / 4096, false, true, false, NN / 4096, NN>(Z, TW);
}
template <int NN, int NZ> __device__ __forceinline__ void fft_conv(LAS cplx* Z, const LAS cplx* TW, const cplx* const (&Kp)[NZ]) {
    constexpr int R4 = NN / 4096, NIT = NN / R4 / 512, ZSTR = NN + NN / 16;
    const int tid = opaque_tid();
    f32x4 kk[NZ][NIT][R4 / 2];
#pragma unroll
    for (int z = 0; z < NZ; ++z)
#pragma unroll
        for (int i = 0; i < NIT; ++i)
#pragma unroll
            for (int h = 0; h < R4 / 2; ++h) kk[z][i][h] = *(const f32x4*)(Kp[z] + R4 * (tid + 512 * i) + 2 * h);
    fft_pass<16, false, false, true, NN, NN, NZ>(Z, TW); fft_pass<16, false, false, false, NN / 16, NN, NZ>(Z, TW); fft_pass<16, false, false, false, NN / 256, NN, NZ>(Z, TW);
#pragma unroll
    for (int z = 0; z < NZ; ++z)
#pragma unroll
        for (int i = 0; i < NIT; ++i) {
            LAS cplx* zp = Z + z * ZSTR + padidxN<NN>(R4 * (tid + 512 * i));
            cplx x[R4], kc[R4];
#pragma unroll
            for (int h = 0; h < R4 / 2; ++h) { const f32x4 v = *(const LAS f32x4*)(zp + 2 * h); x[2 * h] = (cplx){v.x, v.y}; x[2 * h + 1] = (cplx){v.z, v.w}; kc[2 * h] = (cplx){kk[z][i][h].x, kk[z][i][h].y}; kc[2 * h + 1] = (cplx){kk[z][i][h].z, kk[z][i][h].w}; }
            reg_fft_fwd<R4, false>(x);
#pragma unroll
            for (int q = 0; q < R4; ++q) x[q] = cmul(x[q], kc[bitrev_r<R4>(q)]);
            reg_fft_inv<R4, false>(x);
#pragma unroll
            for (int h = 0; h < R4 / 2; ++h) { f32x4 v; v.x = x[2 * h].x; v.y = x[2 * h].y; v.z = x[2 * h + 1].x; v.w = x[2 * h + 1].y; *(LAS f32x4*)(zp + 2 * h) = v; }
        }
    LBAR();
    fft_pass<16, true, false, false, NN / 256, NN, NZ>(Z, TW); fft_pass<16, true, false, false, NN / 16, NN, NZ>(Z, TW); fft_pass<16, true, false, true, NN, NN, NZ>(Z, TW);
}
__device__ __forceinline__ void tw_init(LAS cplx* TW) {
    for (int j = opaque_tid(); j < 1024; j += 512) { const float r = (float)j * (1.0f / 16384.0f); cplx w; w.x = __builtin_amdgcn_cosf(r); w.y = __builtin_amdgcn_sinf(r); TW[j] = w; }
}

constexpr int FFT_LDS = (16384 + 1024) * 8;
constexpr int FFT_AUX = FFT_LDS;
constexpr int FFT_TW = FFT_LDS + 544;

__device__ __forceinline__ void taps_item(LAS unsigned char* lds, int it, const float* HID, const float* w3, unsigned char* outb) {
    const int tid = opaque_tid();
    int lsel, tt, ct;
    if (it < 512) { lsel = 0; tt = it >> 5; ct = it & 31; } else { lsel = 1; const int r = it - 512; tt = r >> 5; ct = r & 31; }
    const int L = lsel ? 4096 : 8192, t = tt * 512 + tid;
    LAS float* W = (LAS float*)lds;
    LBAR();
    for (int i = tid; i < 4096; i += 512) { const int j = i >> 6, c = i & 63; W[c * 64 + j] = w3[(size_t)j * 2048 + ct * 64 + c]; }
    f32x4 h[16];
    const f32x4* hr = (const f32x4*)(HID + ((lsel ? (size_t)8192 : 0) + t) * 64);
#pragma unroll
    for (int q = 0; q < 16; ++q) h[q] = hr[q];
    LBAR();
    float* dst = (float*)(outb + OUT_TAPS) + (lsel ? (size_t)2048 * 8192 : 0) + (size_t)(ct * 64) * L + t;
#pragma unroll 2
    for (int c = 0; c < 64; ++c) {
        float d0 = 0.f, d1 = 0.f;
#pragma unroll
        for (int q = 0; q < 16; ++q) { const f32x4 w = *(const LAS f32x4*)(W + c * 64 + 4 * q); d0 += h[q].x * w.x + h[q].z * w.z; d1 += h[q].y * w.y + h[q].w * w.w; }
        dst[(size_t)c * L] = d0 + d1;
    }
}

__device__ __forceinline__ void spectrum_item(LAS unsigned char* lds, int item, const float* hy_bias, unsigned char* outb) {
    const int tid = opaque_tid();
    const int lsel = item >> 10, order = (item >> 9) & 1, ch = item & 511;
    const int L = lsel ? 4096 : 8192, N = 2 * L;
#define PADL(p_) (lsel ? padidxN<8192>(p_) : padidxN<16384>(p_))
    LAS f32x2* Z = (LAS f32x2*)lds; LAS cplx* TW = (LAS cplx*)(lds + FFT_TW); tw_init(TW);
    LAS float* aux = (LAS float*)(lds + FFT_AUX);
    const float* TF = (const float*)(outb + OUT_TAPS) + (lsel ? (size_t)2048 * 8192 : 0) + (size_t)(order * 512 + ch) * L;
    const float* TB = TF + (size_t)1024 * L;
    LBAR();
    const float delta = 3.0701134573253945f + (float)ch * ((15.350567286626973f - 3.0701134573253945f) / 511.0f);
    float ss = 0.f;
    for (int t0 = tid; t0 < L; t0 += 8 * 512) {
        float tf[8], tb[8];
#pragma unroll
        for (int i = 0; i < 8; ++i) { tf[i] = TF[t0 + 512 * i]; tb[i] = TB[t0 + 512 * i]; }
#pragma unroll
        for (int i = 0; i < 8; ++i) {
            const int t = t0 + 512 * i;
            const float dec = __expf(-((float)t / (float)(L - 1)) * delta);
            const float hf = tf[i] * dec, hb = tb[i] * dec;
            f32x2 o; o.y = 0.f; o.x = hf; Z[PADL(t)] = o; ss += hf * hf;
            if (t >= 1) { o.x = hb; Z[PADL(N - t)] = o; ss += hb * hb; }
        }
    }
    if (tid == 0) { f32x2 o; o.x = 0.f; o.y = 0.f; Z[PADL(L)] = o; }
    ss = wave_sum(ss);
    if ((tid & 63) == 0) aux[128 + (tid >> 6)] = ss;
    LBAR();
    float tot = 0.f;
#pragma unroll
    for (int w = 0; w < 8; ++w) tot += aux[128 + w];
    const float invN = 1.0f / (float)N;
    const float scale = rsqrtf(tot) * invN;
    for (int p = tid; p < N; p += 512) { f32x2 z = Z[PADL(p)]; z.x *= scale; if (p == 0) z.x += hy_bias[order * 512 + ch] * invN; Z[PADL(p)] = z; }
    LBAR();
    if (lsel) fft_fwd_full<8192>(Z, TW); else fft_fwd_full<16384>(Z, TW);
    f32x2* dst = (f32x2*)(outb + (lsel ? OUT_SPEC1 : OUT_SPEC0)) + (size_t)(order * 512 + ch) * N;
    for (int p = tid; p < N; p += 512) dst[p] = Z[PADL(p)];
    LBAR();
}
#undef PADL

struct Raw8 { u32x4 raw; float left, right; };
__device__ __forceinline__ Raw8 load_raw8(const bf16_t* base, int n0, int L) {
    Raw8 r; r.raw = *(const u32x4*)(base + n0);
    r.left = n0 > 0 ? bf1(base[n0 - 1]) : 0.f; r.right = (n0 + 8 < L) ? bf1(base[n0 + 8]) : 0.f; return r;
}
__device__ __forceinline__ void conv_raw8(const Raw8& r, float w0, float w1, float w2, float b, float (&out)[8]) {
    float x[10]; x[0] = r.left; x[9] = r.right;
    x[1] = bflo(r.raw.x); x[2] = bfhi(r.raw.x); x[3] = bflo(r.raw.y); x[4] = bfhi(r.raw.y); x[5] = bflo(r.raw.z); x[6] = bfhi(r.raw.z); x[7] = bflo(r.raw.w); x[8] = bfhi(r.raw.w);
#pragma unroll
    for (int e = 0; e < 8; ++e) out[e] = w0 * x[e] + w1 * x[e + 1] + w2 * x[e + 2] + b;
}
template <int NN, int NZ> __device__ __forceinline__ void hyena_body(LAS unsigned char* lds, int pair, int ch0, const bf16_t* HX, bf16_t* YH, const float* conv_w, const float* conv_b, const unsigned char* outb) {
    constexpr int L = NN / 2, NIT = L / 8 / 512, lsel = (NN == 8192), ZSTR = NN + NN / 16;
    const int tid = opaque_tid();
    size_t sb[NZ][2];
    const cplx* K1[NZ]; const cplx* K2[NZ];
#pragma unroll
    for (int z = 0; z < NZ; ++z) {
        const int ch = ch0 + z;
#pragma unroll
        for (int bb = 0; bb < 2; ++bb) { const int b = 2 * pair + bb; sb[z][bb] = lsel ? ((size_t)MPR * 512 + ((size_t)b * 512 + ch) * 4096) : (((size_t)b * 512 + ch) * 8192); }
        K1[z] = (const f32x2*)(outb + (lsel ? OUT_SPEC1 : OUT_SPEC0)) + (size_t)ch * NN; K2[z] = K1[z] + (size_t)512 * NN;
    }
    LAS f32x2* Z = (LAS f32x2*)lds; LAS cplx* TW = (LAS cplx*)(lds + FFT_TW);
    const bf16_t* X1 = HX; const bf16_t* X2 = HX + HXN; const bf16_t* XV = HX + 2 * HXN;
    Raw8 rv[NZ][NIT][2], rx[NZ][NIT][2];
#pragma unroll
    for (int z = 0; z < NZ; ++z)
#pragma unroll
        for (int i = 0; i < NIT; ++i)
#pragma unroll
            for (int bb = 0; bb < 2; ++bb) { rv[z][i][bb] = load_raw8(XV + sb[z][bb], 8 * (tid + 512 * i), L); rx[z][i][bb] = load_raw8(X1 + sb[z][bb], 8 * (tid + 512 * i), L); }
    tw_init(TW);
#pragma unroll
    for (int z = 0; z < NZ; ++z) {
        const int ch = ch0 + z;
        const float w0 = conv_w[1024 + ch], w1 = conv_w[2560 + 1024 + ch], w2 = conv_w[2 * 2560 + 1024 + ch], bc = conv_b[1024 + ch];
#pragma unroll
        for (int i = 0; i < NIT; ++i) {
            const int n0 = 8 * (tid + 512 * i); float a[8], c[8];
            conv_raw8(rv[z][i][0], w0, w1, w2, bc, a); conv_raw8(rv[z][i][1], w0, w1, w2, bc, c);
#pragma unroll
            for (int e = 0; e < 4; ++e) { f32x4 o; o.x = a[2 * e]; o.y = c[2 * e]; o.z = a[2 * e + 1]; o.w = c[2 * e + 1]; *(LAS f32x4*)(Z + z * ZSTR + padidxN<NN>(n0) + 2 * e) = o; }
        }
    }
    LBAR();
    fft_conv<NN, NZ>(Z, TW, K1);
#pragma unroll
    for (int z = 0; z < NZ; ++z) {
        const int ch = ch0 + z;
        const float w0 = conv_w[ch], w1 = conv_w[2560 + ch], w2 = conv_w[2 * 2560 + ch], bc = conv_b[ch];
#pragma unroll
        for (int i = 0; i < NIT; ++i) {
            const int n0 = 8 * (tid + 512 * i); float a[8], c[8];
            conv_raw8(rx[z][i][0], w0, w1, w2, bc, a); conv_raw8(rx[z][i][1], w0, w1, w2, bc, c);
#pragma unroll
            for (int e = 0; e < 4; ++e) { LAS f32x4* zp4 = (LAS f32x4*)(Z + z * ZSTR + padidxN<NN>(n0) + 2 * e); const f32x4 y = *zp4; f32x4 o; o.x = a[2 * e] * y.x; o.y = c[2 * e] * y.y; o.z = a[2 * e + 1] * y.z; o.w = c[2 * e + 1] * y.w; *zp4 = o; }
        }
#pragma unroll
        for (int i = 0; i < NIT; ++i)
#pragma unroll
            for (int bb = 0; bb < 2; ++bb) rx[z][i][bb] = load_raw8(X2 + sb[z][bb], 8 * (tid + 512 * i), L);
    }
    LBAR();
    fft_conv<NN, NZ>(Z, TW, K2);
#pragma unroll
    for (int z = 0; z < NZ; ++z) {
        const int ch = ch0 + z;
        const float w0 = conv_w[512 + ch], w1 = conv_w[2560 + 512 + ch], w2 = conv_w[2 * 2560 + 512 + ch], bc = conv_b[512 + ch];
#pragma unroll
        for (int i = 0; i < NIT; ++i) {
            const int n0 = 8 * (tid + 512 * i); float a[8], c[8];
            conv_raw8(rx[z][i][0], w0, w1, w2, bc, a); conv_raw8(rx[z][i][1], w0, w1, w2, bc, c);
            float ya[8], yc[8];
#pragma unroll
            for (int e = 0; e < 4; ++e) { const f32x4 y = *(const LAS f32x4*)(Z + z * ZSTR + padidxN<NN>(n0) + 2 * e); ya[2 * e] = a[2 * e] * y.x; yc[2 * e] = c[2 * e] * y.y; ya[2 * e + 1] = a[2 * e + 1] * y.z; yc[2 * e + 1] = c[2 * e + 1] * y.w; }
            u32x4 wa, wc2;
            wa.x = pk2(ya[0], ya[1]); wa.y = pk2(ya[2], ya[3]); wa.z = pk2(ya[4], ya[5]); wa.w = pk2(ya[6], ya[7]);
            wc2.x = pk2(yc[0], yc[1]); wc2.y = pk2(yc[2], yc[3]); wc2.z = pk2(yc[4], yc[5]); wc2.w = pk2(yc[6], yc[7]);
            *(u32x4*)(YH + sb[z][0] + n0) = wa; *(u32x4*)(YH + sb[z][1] + n0) = wc2;
        }
    }
    LBAR();
}
constexpr int HY_ITEMS = 1024 + 2048;
__device__ __forceinline__ void hyena_item(LAS unsigned char* lds, int item, const bf16_t* HX, bf16_t* YH, const float* conv_w, const float* conv_b, const unsigned char* outb) {
    if (item < 1024) hyena_body<16384, 1>(lds, item >> 9, item & 511, HX, YH, conv_w, conv_b, outb);
    else { const int r = 2 * (item - 1024); hyena_body<8192, 2>(lds, r >> 9, r & 511, HX, YH, conv_w, conv_b, outb); }
}

#define DPPF(oldv, x, ctrl, rmask) __builtin_bit_cast(float, __builtin_amdgcn_update_dpp(__builtin_bit_cast(int, (float)(oldv)), __builtin_bit_cast(int, (x)), (ctrl), (rmask), 0xf, false))
__device__ __forceinline__ float scan_add64(float x) {
    x += DPPF(0.f, x, 0x111, 0xf); x += DPPF(0.f, x, 0x112, 0xf); x += DPPF(0.f, x, 0x114, 0xf); x += DPPF(0.f, x, 0x118, 0xf);
    x += DPPF(0.f, x, 0x142, 0xa); x += DPPF(0.f, x, 0x143, 0xc); return x;
}
__device__ __forceinline__ float scan_max64(float x) {
    const float ninf = -__builtin_inff();
    x = fmaxf(x, DPPF(ninf, x, 0x111, 0xf)); x = fmaxf(x, DPPF(ninf, x, 0x112, 0xf)); x = fmaxf(x, DPPF(ninf, x, 0x114, 0xf)); x = fmaxf(x, DPPF(ninf, x, 0x118, 0xf));
    x = fmaxf(x, DPPF(ninf, x, 0x142, 0xa)); x = fmaxf(x, DPPF(ninf, x, 0x143, 0xc)); return x;
}
constexpr int ML_QS = 0, ML_KS = 17408, ML_KWT = 34816, ML_VT = 53248, ML_SM = 71680, ML_TOK = 80896  , ML_NV = 84992, ML_QN = 85504, ML_ROWS = 85760;
__device__ __forceinline__ void mlstm_item(LAS unsigned char* lds, int item, const bf16_t* QKVO, const bf16_t* QK2, const float* GATES, unsigned char* outb) {
    const int tid = opaque_tid(), lane = tid & 63, wave = tid >> 6, fr = lane & 15, fq = lane >> 4;
    int seq, head, dir, cfull, cend;
    if (item < 64) { const int r = item & 31; seq = r >> 3; head = (r >> 1) & 3; dir = r & 1; cfull = item < 32 ? 64 : 0; cend = item < 32 ? 128 : 64; }
    else { const int r = item - 64; seq = 4 + (r >> 3); head = (r >> 1) & 3; dir = r & 1; cfull = 0; cend = 64; }
    const int S = seq < 4 ? 8192 : 4096, tok_base = seq < 4 ? seq * 8192 : MPR + (seq - 4) * 4096, NC = cend;
    bf16_t* Hout = (bf16_t*)(outb + (dir ? OUT_HB : OUT_HF));
    LAS float* NV = (LAS float*)(lds + ML_NV); LAS float* QN = (LAS float*)(lds + ML_QN); LAS float* ROWS = (LAS float*)(lds + ML_ROWS);
    if (tid < 128) NV[tid] = 0.f;
    f32x4 Cacc[8];
#pragma unroll
    for (int k = 0; k < 8; ++k) Cacc[k] = (f32x4){0.f, 0.f, 0.f, 0.f};
    float m_prev = 0.f;
    const int lt = tid >> 3, dg = tid & 7;
    const int gidx_i = (dir * 2) * 4 + head, gidx_f = (dir * 2 + 1) * 4 + head;
    u32x4 rq[2], rk[2], rv[2]; float ig_n, fg_n;
    const int tokl = dir ? 63 - lane : lane;
    LAS f32x4* TOKS = (LAS f32x4*)(lds + ML_TOK);
#define ML_LOAD(cidx) do { const int c0_ = dir ? (S - 64 * ((cidx) + 1)) : 64 * (cidx); const size_t tk_ = (size_t)(tok_base + c0_ + lane); \
        const bf16_t* qp_ = QK2 + tk_ * 1024 + head * 128 + 16 * wave; const bf16_t* vp_ = QKVO + tk_ * 2048 + 1024 + head * 128 + 16 * wave; \
        rq[0] = *(const u32x4*)qp_; rq[1] = *(const u32x4*)(qp_ + 8); rk[0] = *(const u32x4*)(qp_ + 512); rk[1] = *(const u32x4*)(qp_ + 520); rv[0] = *(const u32x4*)vp_; rv[1] = *(const u32x4*)(vp_ + 8); \
        const float* gp_ = GATES + (size_t)(tok_base + c0_ + tokl) * 16; ig_n = gp_[gidx_i]; fg_n = gp_[gidx_f]; } while (0)
    ML_LOAD(0);
    LBAR();
    for (int c = 0; c < NC; ++c) {
        const int c0 = dir ? (S - 64 * (c + 1)) : 64 * c;
        const float ig = ig_n, fg = fg_n;
        const float lf = fminf(fg, 0.f) - __logf(1.f + __expf(-fabsf(fg)));
        const float bs = scan_add64(lf);
        const float uu = ig - bs;
        const float cu = scan_max64(uu);
        const float Mv = fmaxf(m_prev, cu);
        const float b_last = __builtin_bit_cast(float, __builtin_amdgcn_readlane(__builtin_bit_cast(int, bs), 63)), M_last = __builtin_bit_cast(float, __builtin_amdgcn_readlane(__builtin_bit_cast(int, Mv), 63));
        const float w_scan = __expf(uu - M_last), s_old = __expf(m_prev - M_last);
        if (wave == 0) { f32x4 tk; tk.x = __expf(m_prev - Mv); tk.y = __expf(fminf(-bs - Mv, 80.f)); tk.z = __expf(fminf(M_last - Mv, 60.f)); tk.w = 0.f; TOKS[tokl] = tk; }
        const float w_tok = dir ? xshfl(w_scan, 63 - lane) : w_scan;
        {
            LAS unsigned char* qrow = lds + ML_QS + lane * 272 + 32 * wave; LAS unsigned char* krow = lds + ML_KS + lane * 272 + 32 * wave;
            *(LAS u32x4*)qrow = rq[0]; *(LAS u32x4*)(qrow + 16) = rq[1];
            u32x4 kws[2];
#pragma unroll
            for (int h = 0; h < 2; ++h)
#pragma unroll
                for (int e = 0; e < 4; ++e) {
                    const int d = 16 * wave + 8 * h + 2 * e;
                    const unsigned kw = pk2(bflo(rk[h][e]) * w_tok, bfhi(rk[h][e]) * w_tok); kws[h][e] = kw;
                    *(LAS bf16_t*)(lds + ML_KWT + d * 144 + lane * 2) = (bf16_t)(kw & 0xffffu);
                    *(LAS bf16_t*)(lds + ML_KWT + (d + 1) * 144 + lane * 2) = (bf16_t)(kw >> 16);
                    *(LAS bf16_t*)(lds + ML_VT + d * 144 + lane * 2) = (bf16_t)(rv[h][e] & 0xffffu);
                    *(LAS bf16_t*)(lds + ML_VT + (d + 1) * 144 + lane * 2) = (bf16_t)(rv[h][e] >> 16);
                }
            *(LAS u32x4*)krow = kws[0]; *(LAS u32x4*)(krow + 16) = kws[1];
        }
        LBAR();
        if (c + 1 < NC) ML_LOAD(c + 1);
        const bool full = (c >= cfull);
        if (full) {
            const int rt = wave >> 1, ct0 = 2 * (wave & 1);
            f32x4 sacc[2] = {(f32x4){0.f, 0.f, 0.f, 0.f}, (f32x4){0.f, 0.f, 0.f, 0.f}};
#pragma unroll
            for (int ks = 0; ks < 4; ++ks) {
                const bf16x8 qf = *(const LAS bf16x8*)(lds + ML_QS + (16 * rt + fr) * 272 + (32 * ks + 8 * fq) * 2);
#pragma unroll
                for (int cc = 0; cc < 2; ++cc) { const bf16x8 kf = *(const LAS bf16x8*)(lds + ML_KS + (16 * (ct0 + cc) + fr) * 272 + (32 * ks + 8 * fq) * 2); sacc[cc] = __builtin_amdgcn_mfma_f32_16x16x32_bf16(kf, qf, sacc[cc], 0, 0, 0); }
            }
            const int t = 16 * rt + fr;
            const float rT = TOKS[t].z;
            float rs = 0.f;
#pragma unroll
            for (int cc = 0; cc < 2; ++cc) {
                float sv[4];
#pragma unroll
                for (int j = 0; j < 4; ++j) { const int s = 16 * (ct0 + cc) + 4 * fq + j; const bool keep = dir ? (s >= t) : (s <= t); const float v = keep ? sacc[cc][j] * rT : 0.f; sv[j] = v; rs += v; }
                u32x2 w; w.x = pk2(sv[0], sv[1]); w.y = pk2(sv[2], sv[3]);
                *(LAS u32x2*)(lds + ML_SM + t * 144 + (16 * (ct0 + cc) + 4 * fq) * 2) = w;
            }
            rs += xshfl_xor(rs, 16); rs += xshfl_xor(rs, 32);
            if (fq == 0) ROWS[t * 2 + (wave & 1)] = rs;
            float qd = 0.f;
            const u32x4 q0 = *(const LAS u32x4*)(lds + ML_QS + lt * 272 + 32 * dg), q1 = *(const LAS u32x4*)(lds + ML_QS + lt * 272 + 32 * dg + 16);
#pragma unroll
            for (int e = 0; e < 4; ++e) { qd += bflo(q0[e]) * NV[16 * dg + 2 * e] + bfhi(q0[e]) * NV[16 * dg + 2 * e + 1]; qd += bflo(q1[e]) * NV[16 * dg + 8 + 2 * e] + bfhi(q1[e]) * NV[16 * dg + 8 + 2 * e + 1]; }
            qd += DPPF(0.f, qd, 0x101, 0xf); qd += DPPF(0.f, qd, 0x102, 0xf); qd += DPPF(0.f, qd, 0x104, 0xf);
            if (dg == 0) QN[lt] = qd;
        }
        if (full) LBAR();
        {
            bf16x8 vf[2];
#pragma unroll
            for (int ks = 0; ks < 2; ++ks) vf[ks] = *(const LAS bf16x8*)(lds + ML_VT + (16 * wave + fr) * 144 + (32 * ks + 8 * fq) * 2);
            if (full) {
            bf16x8 cf[4];
#pragma unroll
            for (int ks = 0; ks < 4; ++ks) {
                u32x4 w; w.x = pk2(Cacc[2 * ks][0], Cacc[2 * ks][1]); w.y = pk2(Cacc[2 * ks][2], Cacc[2 * ks][3]); w.z = pk2(Cacc[2 * ks + 1][0], Cacc[2 * ks + 1][1]); w.w = pk2(Cacc[2 * ks + 1][2], Cacc[2 * ks + 1][3]);
                cf[ks] = __builtin_bit_cast(bf16x8, w);
            }
#pragma unroll
            for (int rt = 0; rt < 4; ++rt) {
                f32x4 o2 = (f32x4){0.f, 0.f, 0.f, 0.f}, o1 = (f32x4){0.f, 0.f, 0.f, 0.f};
#pragma unroll
                for (int ks = 0; ks < 2; ++ks) { const bf16x8 sf = *(const LAS bf16x8*)(lds + ML_SM + (16 * rt + fr) * 144 + (32 * ks + 8 * fq) * 2); o2 = __builtin_amdgcn_mfma_f32_16x16x32_bf16(vf[ks], sf, o2, 0, 0, 0); }
#pragma unroll
                for (int ks = 0; ks < 4; ++ks) {
                    const u32x2 qlo = *(const LAS u32x2*)(lds + ML_QS + (16 * rt + fr) * 272 + (32 * ks + 4 * fq) * 2), qhi = *(const LAS u32x2*)(lds + ML_QS + (16 * rt + fr) * 272 + (32 * ks + 16 + 4 * fq) * 2);
                    u32x4 w; w.x = qlo.x; w.y = qlo.y; w.z = qhi.x; w.w = qhi.y;
                    o1 = __builtin_amdgcn_mfma_f32_16x16x32_bf16(cf[ks], __builtin_bit_cast(bf16x8, w), o1, 0, 0, 0);
                }
                const int t = 16 * rt + fr;
                const f32x4 tk = TOKS[t]; const float it = tk.x, el = tk.y;
                const float den = it * QN[t] + ROWS[2 * t] + ROWS[2 * t + 1];
                const float r = __builtin_amdgcn_rcpf(fmaxf(fabsf(den), el));
                u32x2 w; w.x = pk2((it * o1[0] + o2[0]) * r, (it * o1[1] + o2[1]) * r); w.y = pk2((it * o1[2] + o2[2]) * r, (it * o1[3] + o2[3]) * r);
                *(u32x2*)(Hout + (size_t)(tok_base + c0 + t) * 512 + head * 128 + 16 * wave + 4 * fq) = w;
            }
            }
#pragma unroll
            for (int kt = 0; kt < 8; ++kt) {
                Cacc[kt] = Cacc[kt] * s_old;
#pragma unroll
                for (int ks = 0; ks < 2; ++ks) { const bf16x8 kwf = *(const LAS bf16x8*)(lds + ML_KWT + (16 * kt + fr) * 144 + (32 * ks + 8 * fq) * 2); Cacc[kt] = __builtin_amdgcn_mfma_f32_16x16x32_bf16(kwf, vf[ks], Cacc[kt], 0, 0, 0); }
                if (kt & 1) asm volatile("" ::: "memory");
            }
            const int d = tid >> 2, part = tid & 3;
            const u32x4 k0 = *(const LAS u32x4*)(lds + ML_KWT + d * 144 + part * 32), k1 = *(const LAS u32x4*)(lds + ML_KWT + d * 144 + part * 32 + 16);
            float sm = 0.f;
#pragma unroll
            for (int e = 0; e < 4; ++e) sm += bflo(k0[e]) + bfhi(k0[e]) + bflo(k1[e]) + bfhi(k1[e]);
            sm += DPPF(0.f, sm, 0x101, 0xf); sm += DPPF(0.f, sm, 0x102, 0xf);
            if (part == 0) NV[d] = s_old * NV[d] + sm;
        }
        m_prev = b_last + M_last;
        LBAR();
    }
#undef ML_LOAD
}

#define XB_TMO      128
#define XB_XCNT(j)  (256  + 64 * (j))
#define XB_XSUB(j)  (1280 + 64 * (j))
#define XB_XGEN(j)  (2304 + 64 * (j))
#define XB_TOP      3328
#define XB_TOPGEN   3392
#define XCD_BAR_WORDS 3456
#define XB_SPIN_CAP (1u << 22)
__device__ __forceinline__ unsigned xb_ld(unsigned* p)              { return __hip_atomic_load(p, __ATOMIC_RELAXED, __HIP_MEMORY_SCOPE_AGENT); }
__device__ __forceinline__ unsigned xb_add(unsigned* p, unsigned v) { return __hip_atomic_fetch_add(p, v, __ATOMIC_RELAXED, __HIP_MEMORY_SCOPE_AGENT); }
__device__ __forceinline__ unsigned xb_xcc_id() { return (unsigned)__builtin_amdgcn_s_getreg((3 << 11) | 20) & 0xFu; }
#define XB_SPIN(cond, bar) do { unsigned _sp = 0; while (cond) { __builtin_amdgcn_s_sleep(1); \
    if ((++_sp & 255u) == 0u) { if (xb_ld(&(bar)[XB_TMO])) break; if (_sp > XB_SPIN_CAP) { atomicAdd(&(bar)[XB_TMO], 1u); break; } } } } while (0)
struct XcdBarrier { unsigned* bar; unsigned x; volatile LAS unsigned* st; };
__device__ __forceinline__ XcdBarrier xcd_barrier_post(unsigned* bar, volatile LAS unsigned* st) {
    XcdBarrier b; b.bar = bar; b.x = xb_xcc_id(); b.st = st;
    if (opaque_tid() == 0) (void)xb_add(&bar[XB_XCNT(b.x)], 1u);
    return b;
}
__device__ __forceinline__ void xcd_barrier_complete(unsigned* bar, unsigned x, unsigned& nloc, unsigned& nx) {
    const unsigned G = gridDim.x * gridDim.y * gridDim.z;
    unsigned sum, cnt, mine, sp = 0u;
    for (;;) {
        sum = 0u; cnt = 0u; mine = 0u;
#pragma unroll
        for (unsigned j = 0; j < 16; ++j) { const unsigned c = xb_ld(&bar[XB_XCNT(j)]); sum += c; cnt += (c > 0u) ? 1u : 0u; mine = (j == x) ? c : mine; }
        if (sum == G) break;
        __builtin_amdgcn_s_sleep(1);
        if ((++sp & 255u) == 0u) { if (xb_ld(&bar[XB_TMO])) break; if (sp > XB_SPIN_CAP) { atomicAdd(&bar[XB_TMO], 1u); break; } }
    }
    nloc = mine > 0u ? mine : 1u; nx = cnt > 0u ? cnt : 1u;
}
__device__ __forceinline__ void xcd_barrier(const XcdBarrier& b) {
    asm volatile("s_waitcnt vmcnt(0)" ::: "memory");
    __syncthreads();
    if (opaque_tid() == 0) {
        unsigned* bar = b.bar;
        __builtin_amdgcn_s_waitcnt(0);
        unsigned nloc = b.st[0], nx = b.st[1];
        if (nloc == 0u) { xcd_barrier_complete(bar, b.x, nloc, nx); b.st[0] = nloc; b.st[1] = nx; }
        const unsigned old = xb_add(&bar[XB_XSUB(b.x)], 1u);
        const unsigned gen = old / nloc;
        if (old + 1u == (gen + 1u) * nloc) {
            __builtin_amdgcn_fence(__ATOMIC_RELEASE, "agent");
            asm volatile("s_waitcnt vmcnt(0)" ::: "memory");
            const unsigned og = xb_add(&bar[XB_TOP], 1u);
            const unsigned tg = og / nx;
            if (og + 1u == (tg + 1u) * nx) xb_add(&bar[XB_TOPGEN], 1u);
            else XB_SPIN(xb_ld(&bar[XB_TOPGEN]) == tg, bar);
            __builtin_amdgcn_fence(__ATOMIC_ACQUIRE, "agent");
            xb_add(&bar[XB_XGEN(b.x)], 1u);
            asm volatile("s_waitcnt vmcnt(0)" ::: "memory");
        } else {
            XB_SPIN(xb_ld(&bar[XB_XGEN(b.x)]) == gen, bar);
            __builtin_amdgcn_fence(__ATOMIC_ACQUIRE, "agent");
            asm volatile("s_waitcnt vmcnt(0)" ::: "memory");
        }
    }
    __syncthreads();
}

struct Args { const float* in[23]; float* out; unsigned char* ws; };

__device__ __forceinline__ void transpose_item(const float* W, int pitch, int K, bf16_t* WT, int n0, int dst_row0, int k0, LAS float* scr, int lane) {
#pragma unroll 8
    for (int i = 0; i < 32; ++i) { const int kk = 2 * i + (lane >> 5); scr[kk * 33 + (lane & 31)] = W[(size_t)(k0 + kk) * pitch + n0 + (lane & 31)]; }
    LDS_WAIT(); asm volatile("" ::: "memory");
    const int c = lane & 7;
#pragma unroll
    for (int j = 0; j < 4; ++j) { const int n = (lane >> 3) + 8 * j; const LAS float* s = scr + (8 * c) * 33 + n;
        u32x4 o; o.x = pk2(s[0 * 33], s[1 * 33]); o.y = pk2(s[2 * 33], s[3 * 33]); o.z = pk2(s[4 * 33], s[5 * 33]); o.w = pk2(s[6 * 33], s[7 * 33]);
        *(u32x4*)(WT + (size_t)(dst_row0 + n) * K + k0 + 8 * c) = o; }
    LDS_WAIT(); asm volatile("" ::: "memory");
}

__global__ void __launch_bounds__(512, 2) fwd_kernel(Args a) {
    extern __shared__ __attribute__((aligned(16))) unsigned char lds_raw[];
    LAS unsigned char* lds = (LAS unsigned char*)lds_raw;
    cg::grid_group grid = cg::this_grid();
#define PHASE_IDS const int tid = opaque_tid(), lane = tid & 63, wave = __builtin_amdgcn_readfirstlane(tid >> 6); const int gw = blockIdx.x * 8 + wave, NGW = G * 8; (void)lane; (void)gw; (void)NGW; (void)tid
    const int G = gridDim.x;
    LAS unsigned* bst = (LAS unsigned*)(lds + LDS_BYTES - 32);
    if (opaque_tid() == 0) { bst[0] = 0u; bst[1] = 0u; }
    __syncthreads();
    const XcdBarrier xbar = xcd_barrier_post((unsigned*)(a.ws + WS_BAR), (volatile LAS unsigned*)bst);
#define GSYNC() xcd_barrier(xbar)
    unsigned char* ws = a.ws; unsigned char* outb = (unsigned char*)a.out;
    unsigned* ctl = (unsigned*)(ws + WS_CTL);
    bf16_t* W1T = (bf16_t*)(ws + WS_W1T); bf16_t* W2T = (bf16_t*)(ws + WS_W2T); bf16_t* W3T = (bf16_t*)(ws + WS_W3T); bf16_t* W4T = (bf16_t*)(ws + WS_W4T);
    float* HID = (float*)(ws + WS_HID); float* GATES = (float*)(ws + WS_GATES);
    bf16_t* R1 = (bf16_t*)(ws + WS_R1) + R1_PAD_ROWS * 1024;
    bf16_t* YH = (bf16_t*)(ws + WS_YH); bf16_t* HX = (bf16_t*)(ws + WS_HX); bf16_t* QKVO = (bf16_t*)(ws + WS_QKVO); bf16_t* ACT = (bf16_t*)(ws + WS_ACT);
    const float* xp = a.in[0]; const float* xs = a.in[1];
    bf16_t* H2U = (bf16_t*)(ws + WS_H2U); float* SS = (float*)(ws + WS_SS);

    {
        PHASE_IDS;
        if (blockIdx.x == 0 && tid == 0) { ctl[0] = 0u; }
        for (int i = blockIdx.x * 512 + tid - 1; i < MTOK + 512; i += G * 512) SS[i] = 0.f;
#ifdef REP_P0
        for (int rep_ = 0; rep_ < 2; ++rep_) {
#endif
        LAS float* scr = (LAS float*)(lds + wave * 8448);
        constexpr int I1 = 16 * 112, I2 = 16 * 32, I3 = 16 * 176, I4 = 44 * 32;
        for (int it = gw; it < I1 + I2 + I3 + I4; it += NGW) {
            int r = it;
            if (r < I1) { const int kb = r / 112, nb = r % 112; transpose_item(a.in[3], PIN, 1024, W1T, 32 * nb, 32 * nb, 64 * kb, scr, lane); continue; } r -= I1;
            if (r < I2) { const int kb = r / 32, nb = r % 32; transpose_item(a.in[16], 1024, 1024, W2T, 32 * nb, 32 * nb, 64 * kb, scr, lane); continue; } r -= I2;
            if (r < I3) { const int kb = r / 176, nb = r % 176; const int n0 = 32 * nb; const int gate = n0 >= FF, cc = gate ? n0 - FF : n0; const int drow = (cc >> 7) * 256 + gate * 128 + (cc & 127);
                transpose_item(a.in[18], FF2, 1024, W3T, n0, drow, 64 * kb, scr, lane); continue; } r -= I3;
            { const int kb = r / 32, nb = r % 32; transpose_item(a.in[21], 1024, FF, W4T, 32 * nb, 32 * nb, 64 * kb, scr, lane); }
        }
        __syncthreads();
        LAS float* GWl = (LAS float*)(lds + 69632);
        for (int i = tid; i < 16 * 1024; i += 512) { const int k = i >> 4, gt = i & 15; GWl[gt * 1024 + k] = a.in[3][(size_t)k * PIN + NP1 + gt]; }
        __syncthreads();
        f32x4 g1[4];
#pragma unroll
        for (int j = 0; j < 4; ++j) g1[j] = ((const f32x4*)a.in[2])[lane + 64 * j];
        f32x4 nx[2][4];
#define P0_LOAD(mm) do { _Pragma("unroll") for (int r_ = 0; r_ < 2; ++r_) { const int mr_ = (mm) + r_; const float* xrow_ = mr_ < MPR ? xp + (size_t)mr_ * DM : xs + (size_t)(mr_ - MPR) * DM; \
            _Pragma("unroll") for (int j_ = 0; j_ < 4; ++j_) nx[r_][j_] = ((const f32x4*)xrow_)[lane + 64 * j_]; } } while (0)
        if (2 * gw < MTOK) P0_LOAD(2 * gw);
        for (int m = 2 * gw; m < MTOK; m += 2 * NGW) {
            f32x4 v[2][4];
#pragma unroll
            for (int r = 0; r < 2; ++r)
#pragma unroll
                for (int j = 0; j < 4; ++j) v[r][j] = nx[r][j];
            if (m + 2 * NGW < MTOK) P0_LOAD(m + 2 * NGW);
#pragma unroll
            for (int r = 0; r < 2; ++r) {
                const int mr = m + r;
                float s = 0.f;
#pragma unroll
                for (int j = 0; j < 4; ++j) s += (v[r][j].x * v[r][j].x + v[r][j].y * v[r][j].y) + (v[r][j].z * v[r][j].z + v[r][j].w * v[r][j].w);
                const float rs = rsqrtf(wave_sum(s) * (1.f / DM) + 1e-6f);
                unsigned long long* o8 = (unsigned long long*)(R1 + (size_t)mr * DM) + lane;
#pragma unroll
                for (int j = 0; j < 4; ++j) { v[r][j] = v[r][j] * rs * g1[j]; o8[64 * j] = (unsigned long long)pk2(v[r][j].x, v[r][j].y) | ((unsigned long long)pk2(v[r][j].z, v[r][j].w) << 32); }
            }
            float p[32];
#pragma unroll
            for (int gt = 0; gt < 16; ++gt) {
                float p0 = 0.f, p1 = 0.f;
#pragma unroll
                for (int j = 0; j < 4; ++j) { const f32x4 w = *(const LAS f32x4*)(GWl + gt * 1024 + 256 * j + 4 * lane);
                    p0 += (v[0][j].x * w.x + v[0][j].y * w.y) + (v[0][j].z * w.z + v[0][j].w * w.w); p1 += (v[1][j].x * w.x + v[1][j].y * w.y) + (v[1][j].z * w.z + v[1][j].w * w.w); }
                p[gt] = p0; p[16 + gt] = p1;
                if ((gt & 3) == 3) asm volatile("" ::: "memory");
            }
            { const bool hi = (lane & 32) != 0;
#pragma unroll
              for (int g = 0; g < 16; ++g) { const float mine = hi ? p[16 + g] : p[g], oth = hi ? p[g] : p[16 + g]; p[g] = mine + xshfl_xor(oth, 32); } }
            { const bool hi = (lane & 16) != 0;
#pragma unroll
              for (int g = 0; g < 8; ++g) { const float mine = hi ? p[8 + g] : p[g], oth = hi ? p[g] : p[8 + g]; p[g] = mine + xshfl_xor(oth, 16); } }
            { const bool hi = (lane & 8) != 0;
#pragma unroll
              for (int g = 0; g < 4; ++g) { const float mine = hi ? p[4 + g] : p[g], oth = hi ? p[g] : p[4 + g]; p[g] = mine + xshfl_xor(oth, 8); } }
            { const bool hi = (lane & 4) != 0;
#pragma unroll
              for (int g = 0; g < 2; ++g) { const float mine = hi ? p[2 + g] : p[g], oth = hi ? p[g] : p[2 + g]; p[g] = mine + xshfl_xor(oth, 4); } }
            { const bool hi = (lane & 2) != 0; const float mine = hi ? p[1] : p[0], oth = hi ? p[0] : p[1]; p[0] = mine + xshfl_xor(oth, 2); }
            p[0] += xshfl_xor(p[0], 1);
            const int gate = ((lane >> 4) & 1) * 8 + ((lane >> 3) & 1) * 4 + ((lane >> 2) & 1) * 2 + ((lane >> 1) & 1);
            if ((lane & 1) == 0) GATES[(size_t)(m + (lane >> 5)) * 16 + gate] = p[0] + a.in[6][gate];
        }
        for (int pos = gw; pos < 12288; pos += NGW) {
            const int L = pos < 8192 ? 8192 : 4096, t = pos < 8192 ? pos : pos - 8192;
            float z = 0.f;
            if (lane == 0) z = (float)t / (float)(L - 1);
            else if (lane <= 32) { const int jb = (lane - 1) & 15; const double frq = 1e-4 + (double)jb * ((15.0 - 1e-4) / 15.0); double r = (double)t * frq / (double)L; r -= floor(r); const float rf = (float)r;
                z = lane <= 16 ? __builtin_amdgcn_cosf(rf) : -__builtin_amdgcn_sinf(rf); }
            float a1 = a.in[8][lane];
            for (int e = 0; e < 33; ++e) a1 += xshfl(z, e) * a.in[7][e * 64 + lane];
            const float h1 = sin_rad(a.in[9][lane] * a1);
            float a2 = a.in[11][lane];
            for (int j = 0; j < 64; ++j) a2 += xshfl(h1, j) * a.in[10][j * 64 + lane];
            HID[(size_t)pos * 64 + lane] = sin_rad(a.in[12][lane] * a2);
        }
#ifdef REP_P0
        __syncthreads(); }
#endif
    }
    grid.sync();

    {
        PHASE_IDS;
        pg8::Gemm g{R1, W1T, 1024, 256, 0, 4, 1, 128};
        pg8::StaticOrder S; S.init(MTOK / 256, NP1 / 256, G, (int)blockIdx.x);
        pg8::EpiG1 E{HX, QKVO};
#ifdef REP_G1
        pg8::gemm_phase<pg8::EpiG1, pg8::StaticOrder, true, true>(lds, g, S, E); GSYNC();
#endif
        pg8::gemm_phase<pg8::EpiG1, pg8::StaticOrder, true, true>(lds, g, S, E);
        __syncthreads();
        for (int it = blockIdx.x; it < 768; it += G) taps_item(lds, it, HID, a.in[13], outb);
    }
    GSYNC();

    {
        PHASE_IDS;
        float cw0[16], cw1[16], cw2[16], cbb[16];
#pragma unroll
        for (int e = 0; e < 16; ++e) { const int col = 1536 + 16 * lane + e; cw0[e] = a.in[4][col]; cw1[e] = a.in[4][2560 + col]; cw2[e] = a.in[4][2 * 2560 + col]; cbb[e] = a.in[5][col]; }
        const float ksc = lane >= 32 ? 0.08838834764831845f : 1.0f;
        constexpr int RUN = 48;
        for (int t0 = gw * RUN; t0 < MTOK; t0 += NGW * RUN) {
            u32x4 pv[2], cv[2], nv[2];
            { const bf16_t* p = QKVO + (size_t)(t0 > 0 ? t0 - 1 : 0) * 2048 + 16 * lane; pv[0] = *(const u32x4*)p; pv[1] = *(const u32x4*)(p + 8); }
            { const bf16_t* p = QKVO + (size_t)t0 * 2048 + 16 * lane; cv[0] = *(const u32x4*)p; cv[1] = *(const u32x4*)(p + 8); }
            for (int i = 0; i < RUN; ++i) {
                const int t = t0 + i;
                { const bf16_t* p = QKVO + (size_t)(t + 1 < MTOK ? t + 1 : t) * 2048 + 16 * lane; nv[0] = *(const u32x4*)p; nv[1] = *(const u32x4*)(p + 8); }
                const float mp = pg8::seq_start(t) ? 0.f : 1.f, mn = pg8::seq_start(t + 1) ? 0.f : 1.f;
                u32x4 o[2];
#pragma unroll
                for (int h = 0; h < 2; ++h)
#pragma unroll
                    for (int e = 0; e < 4; ++e) {
                        const int d0 = 8 * h + 2 * e;
                        const float c0 = mp * cw0[d0] * bflo(pv[h][e]) + cw1[d0] * bflo(cv[h][e]) + mn * cw2[d0] * bflo(nv[h][e]) + cbb[d0];
                        const float c1 = mp * cw0[d0 + 1] * bfhi(pv[h][e]) + cw1[d0 + 1] * bfhi(cv[h][e]) + mn * cw2[d0 + 1] * bfhi(nv[h][e]) + cbb[d0 + 1];
                        o[h][e] = pk2(c0 * fsigmoid(c0) * ksc, c1 * fsigmoid(c1) * ksc);
                    }
                bf16_t* dst = R1 + (size_t)t * 1024 + 16 * lane;
                *(u32x4*)dst = o[0]; *(u32x4*)(dst + 8) = o[1];
                pv[0] = cv[0]; pv[1] = cv[1]; cv[0] = nv[0]; cv[1] = nv[1];
            }
        }
    }
    { __syncthreads(); for (int it = blockIdx.x; it < 2048; it += G) spectrum_item(lds, it, a.in[14], outb); }
    GSYNC();

#if defined(EXP_MLSTM)
    { for (int it = blockIdx.x; it < 192; it += G) { __syncthreads(); mlstm_item(lds, it, QKVO, R1, GATES, outb); } }
    GSYNC();
#endif
#if defined(EXP_HYENA)
    { for (int it = blockIdx.x; it < HY_ITEMS; it += G) { __syncthreads(); hyena_item(lds, it, HX, YH, a.in[4], a.in[5], outb); } }
    GSYNC();
#endif
    {
        PHASE_IDS;
        LAS int* slot = (LAS int*)(lds + LDS_BYTES - 16);
        for (;;) {
            LBAR();
            if (tid == 0) *slot = (int)atomicAdd(ctl, 1u);
            LBAR();
            const int item = *slot;
            if (item >= 192 + HY_ITEMS) break;
            if (item < 192) mlstm_item(lds, item, QKVO, R1, GATES, outb);
            else hyena_item(lds, item - 192, HX, YH, a.in[4], a.in[5], outb);
        }
    }
    GSYNC();

#ifdef REP_P2
    if (blockIdx.x == 0 && opaque_tid() == 0) ((unsigned*)(ws + WS_CTL))[0] = 0u;
    GSYNC();
    {
        const int tid = opaque_tid();
        LAS int* slot = (LAS int*)(lds + LDS_BYTES - 16);
        for (;;) {
            __syncthreads();
            if (tid == 0) *slot = (int)atomicAdd((unsigned*)(ws + WS_CTL), 1u);
            __syncthreads();
            const int item = *slot;
            if (item >= 192 + HY_ITEMS) break;
            if (item < 192) mlstm_item(lds, item, QKVO, R1, GATES, outb);
            else hyena_item(lds, item - 192, HX, YH, a.in[4], a.in[5], outb);
        }
    }
    GSYNC();
#endif
#ifdef REP_SYNC
    for (int i_ = 0; i_ < 10; ++i_) GSYNC();
#endif
    {
        PHASE_IDS;
        const bf16_t* YV = YH;
        const bf16_t* HF = (const bf16_t*)(outb + OUT_HF); const bf16_t* HB = (const bf16_t*)(outb + OUT_HB);
        LAS bf16_t* tl = (LAS bf16_t*)lds;
        u32x4 n0 = (u32x4){0u, 0u, 0u, 0u}, n1 = n0;
#define P2C_SRC(it_) ({ const int tt_ = (it_) >> 3, cb_ = (it_) & 7, tok_ = tt_ * 128; size_t sb_; int S_, s0_; \
            if (tok_ < MPR) { S_ = 8192; s0_ = tok_ & 8191; sb_ = (size_t)(tok_ >> 13) * 512 * 8192; } else { S_ = 4096; const int t2_ = tok_ - MPR; s0_ = t2_ & 4095; sb_ = (size_t)MPR * 512 + (size_t)(t2_ >> 12) * 512 * 4096; } \
            YV + sb_ + (size_t)(cb_ * 64 + (tid >> 3)) * S_ + s0_ + 16 * (tid & 7); })
        if ((int)blockIdx.x < 768 * 8) { const bf16_t* sp = P2C_SRC((int)blockIdx.x); n0 = *(const u32x4*)sp; n1 = *(const u32x4*)(sp + 8); }
        for (int it = blockIdx.x; it < 768 * 8; it += G) {
            const int tt = it >> 3, cb = it & 7, tok0 = tt * 128;
            const u32x4 r0 = n0, r1 = n1;
            if (it + G < 768 * 8) { const bf16_t* sp = P2C_SRC(it + G); n0 = *(const u32x4*)sp; n1 = *(const u32x4*)(sp + 8); }
            LBAR();
            { const int chl = tid >> 3, seg = tid & 7;
              *(LAS u32x4*)(tl + chl * 136 + 16 * seg) = r0; *(LAS u32x4*)(tl + chl * 136 + 16 * seg + 8) = r1; }
            LBAR();
            { const int tk = tid >> 2, cgp = tid & 3; unsigned w[8];
#pragma unroll
              for (int e = 0; e < 8; ++e) { const unsigned lo = tl[(16 * cgp + 2 * e) * 136 + tk], hi = tl[(16 * cgp + 2 * e + 1) * 136 + tk]; w[e] = lo | (hi << 16); }
              bf16_t* dst = R1 + (size_t)(tok0 + tk) * DM + cb * 64 + 16 * cgp;
              u32x4 o0, o1; o0.x = w[0]; o0.y = w[1]; o0.z = w[2]; o0.w = w[3]; o1.x = w[4]; o1.y = w[5]; o1.z = w[6]; o1.w = w[7];
              *(u32x4*)dst = o0; *(u32x4*)(dst + 8) = o1; }
        }
#undef P2C_SRC
        f32x4 mg0 = ((const f32x4*)a.in[15])[2 * lane], mg1 = ((const f32x4*)a.in[15])[2 * lane + 1];
        u32x4 nf, nb, no;
        if (gw < MTOK) { nf = *(const u32x4*)(HF + (size_t)gw * 512 + 8 * lane); nb = *(const u32x4*)(HB + (size_t)gw * 512 + 8 * lane); no = *(const u32x4*)(QKVO + (size_t)gw * 2048 + 1536 + 8 * lane); }
        for (int m = gw; m < MTOK; m += NGW) {
            const u32x4 f = nf, b = nb, o = no;
            if (m + NGW < MTOK) { const size_t m2 = (size_t)(m + NGW); nf = *(const u32x4*)(HF + m2 * 512 + 8 * lane); nb = *(const u32x4*)(HB + m2 * 512 + 8 * lane); no = *(const u32x4*)(QKVO + m2 * 2048 + 1536 + 8 * lane); }
            float h[8]; float ss = 0.f;
#pragma unroll
            for (int e = 0; e < 4; ++e) { h[2 * e] = bflo(f[e]) + bflo(b[e]); h[2 * e + 1] = bfhi(f[e]) + bfhi(b[e]); ss += h[2 * e] * h[2 * e] + h[2 * e + 1] * h[2 * e + 1]; }
            ss += xshfl_xor(ss, 1); ss += xshfl_xor(ss, 2); ss += xshfl_xor(ss, 4); ss += xshfl_xor(ss, 8);
            const float rs = rsqrtf(ss * (1.f / 128.f) + 1e-6f);
            float y[8];
#pragma unroll
            for (int e = 0; e < 4; ++e) { y[2 * e] = h[2 * e] * rs * (e < 2 ? mg0[2 * e] : mg1[2 * e - 4]) * bflo(o[e]); y[2 * e + 1] = h[2 * e + 1] * rs * (e < 2 ? mg0[2 * e + 1] : mg1[2 * e - 3]) * bfhi(o[e]); }
            u32x4 w; w.x = pk2(y[0], y[1]); w.y = pk2(y[2], y[3]); w.z = pk2(y[4], y[5]); w.w = pk2(y[6], y[7]);
            *(u32x4*)(R1 + (size_t)m * DM + 512 + 8 * lane) = w;
        }
    }
    GSYNC();

    {
        PHASE_IDS;
        pg8::Gemm g{R1, W2T, 1024, 256, 0, 128, 0, 0};
        pg8::StaticOrder S; S.init(MTOK / 256, 4, G, (int)blockIdx.x);
        pg8::EpiG2 E{xp, xs, a.out, a.in[17], H2U, SS};
#ifdef REP_G2
        pg8::gemm_phase<pg8::EpiG2, pg8::StaticOrder, true, true>(lds, g, S, E); GSYNC();
#endif
        pg8::gemm_phase<pg8::EpiG2, pg8::StaticOrder, true, true>(lds, g, S, E);
    }
    GSYNC();

    {
        PHASE_IDS;
        pg8::Gemm g{H2U, W3T, 1024, 252, -1, 4, 1, 126};
        pg8::StaticOrder S; S.init(391, 22, G, (int)blockIdx.x);
        pg8::EpiG3 E{a.in[19], a.in[20], ACT, SS};
#ifdef REP_G3
        pg8::gemm_phase<pg8::EpiG3, pg8::StaticOrder, true, true>(lds, g, S, E); GSYNC();
#endif
        pg8::gemm_phase<pg8::EpiG3, pg8::StaticOrder, true, true>(lds, g, S, E);
    }
    GSYNC();

    {
        PHASE_IDS;
        pg8::Gemm g{ACT, W4T, FF, 256, 0, 128, 0, 0};
        pg8::StaticOrder S; S.init(MTOK / 256, 4, G, (int)blockIdx.x);
        pg8::EpiG4 E{a.out};
        pg8::gemm_phase<pg8::EpiG4, pg8::StaticOrder, true, true>(lds, g, S, E);
    }
    GSYNC();

    {
        PHASE_IDS;
        f32x4 gf[4];
#pragma unroll
        for (int j = 0; j < 4; ++j) gf[j] = ((const f32x4*)a.in[22])[lane + 64 * j];
        for (int m = gw; m < MTOK; m += NGW) {
            float* xrow = a.out + (size_t)m * DM;
            f32x4 v[4]; float s = 0.f;
#pragma unroll
            for (int j = 0; j < 4; ++j) { v[j] = ((const f32x4*)xrow)[lane + 64 * j]; s += (v[j].x * v[j].x + v[j].y * v[j].y) + (v[j].z * v[j].z + v[j].w * v[j].w); }
            const float rs = rsqrtf(wave_sum(s) * (1.f / DM) + 1e-6f);
#pragma unroll
            for (int j = 0; j < 4; ++j) ((f32x4*)xrow)[lane + 64 * j] = v[j] * rs * gf[j];
        }
    }
}

extern "C" void kernel_launch(void* const* d_in, const int* in_sizes, int n_in, void* d_out, int out_size, void* d_ws, size_t ws_size, hipStream_t stream) {
    static int grid = 0;
    if (grid == 0) {
        int dev = 0, cus = 0, per_cu = 0;
        (void)hipGetDevice(&dev);
        (void)hipDeviceGetAttribute(&cus, hipDeviceAttributeMultiprocessorCount, dev);
        (void)hipFuncSetAttribute((const void*)fwd_kernel, hipFuncAttributeMaxDynamicSharedMemorySize, LDS_BYTES);
        (void)hipOccupancyMaxActiveBlocksPerMultiprocessor(&per_cu, (const void*)fwd_kernel, 512, LDS_BYTES);
        (void)hipGetLastError();
        grid = cus > 0 ? cus : 256;
        if (n_in != 23 || ws_size < WS_END) fprintf(stderr, "kernel_launch: unexpected n_in %d / ws %zu\n", n_in, ws_size);
    }
    (void)hipMemsetAsync((char*)d_ws + WS_BAR, 0, 16384, stream);
    Args a{};
    for (int i = 0; i < 23; ++i) a.in[i] = (const float*)d_in[i];
    a.out = (float*)d_out; a.ws = (unsigned char*)d_ws;
    void* args[] = {&a};
    hipError_t e = hipLaunchCooperativeKernel((void*)fwd_kernel, dim3(grid), dim3(512), args, LDS_BYTES, stream);
    if (e != hipSuccess) fprintf(stderr, "cooperative launch failed: %s (grid %d)\n", hipGetErrorString(e), grid);
}
```

```cpp
#include <hip/hip_runtime.h>
#include <hip/hip_cooperative_groups.h>
#include <cstdio>
#include <cstdint>
namespace cg = cooperative_groups;

#define LAS __attribute__((address_space(3)))
typedef unsigned short bf16_t;
typedef short bf16x8 __attribute__((ext_vector_type(8)));
typedef short bf16x4 __attribute__((ext_vector_type(4)));
typedef float f32x4 __attribute__((ext_vector_type(4)));
typedef float f32x2 __attribute__((ext_vector_type(2)));
typedef unsigned u32x4 __attribute__((ext_vector_type(4)));
typedef unsigned u32x2 __attribute__((ext_vector_type(2)));

constexpr int MTOK = 98304, MPR = 32768, DM = 1024, NP1 = 3584, PIN = 3600, FF = 2816, FF2 = 5632;
constexpr size_t MiB = 1u << 20;
constexpr size_t HXN = (size_t)MTOK * 512;
constexpr size_t WS_CTL = 0;
constexpr size_t WS_W1T = 1 * MiB;
constexpr size_t WS_W2T = 8 * MiB;
constexpr size_t WS_W3T = 10 * MiB;
constexpr size_t WS_W4T = 21 * MiB;
constexpr size_t WS_HID = 27 * MiB;
constexpr size_t WS_GATES = 30 * MiB;
constexpr size_t WS_R1 = 36 * MiB;
constexpr size_t R1_PAD_ROWS = 256;
constexpr size_t WS_HX = 232 * MiB;
constexpr size_t WS_QKVO = 520 * MiB;
constexpr size_t WS_ACT = WS_HX;
constexpr size_t WS_YH = 904 * MiB;
constexpr size_t WS_H2U = 761 * MiB;
constexpr size_t WS_BAR = 512 * 1024;
constexpr size_t WS_SS = 4096;
constexpr size_t WS_END = 1000 * MiB;
static_assert(WS_H2U >= WS_ACT + (size_t)MTOK * FF * 2 + 2048 && WS_H2U + (size_t)(MTOK + 1024) * 2048 <= WS_END, "ws map");
static_assert(WS_R1 + (R1_PAD_ROWS + MTOK + 1024) * 2048 <= WS_HX, "ws map");
static_assert(WS_ACT + (size_t)MTOK * FF * 2 <= WS_YH, "ws map");
constexpr size_t OUT_SPEC0 = 0;
constexpr size_t OUT_SPEC1 = 128 * MiB;
constexpr size_t OUT_HF = 192 * MiB;
constexpr size_t OUT_HB = 288 * MiB;
constexpr size_t OUT_TAPS = OUT_HF;

constexpr int LDS_BYTES = 150528;

__device__ __forceinline__ unsigned pk2(float lo, float hi) { unsigned r; asm("v_cvt_pk_bf16_f32 %0, %1, %2" : "=v"(r) : "v"(lo), "v"(hi)); return r; }
__device__ __forceinline__ unsigned f2bf(float f) { return pk2(f, f) & 0xffffu; }
__device__ __forceinline__ float bflo(unsigned w) { return __builtin_bit_cast(float, w << 16); }
__device__ __forceinline__ float bfhi(unsigned w) { return __builtin_bit_cast(float, w & 0xffff0000u); }
__device__ __forceinline__ float bf1(bf16_t b) { return __builtin_bit_cast(float, ((unsigned)b) << 16); }
__device__ __forceinline__ int opaque_tid() { int t = (int)__builtin_amdgcn_workitem_id_x(); asm volatile("" : "+v"(t)); return t; }
__device__ __forceinline__ float xshfl(float v, int src) { return __builtin_bit_cast(float, __builtin_amdgcn_ds_bpermute(src << 2, __builtin_bit_cast(int, v))); }
__device__ __forceinline__ float xshfl_xor(float v, int m) { return xshfl(v, (opaque_tid() & 63) ^ m); }
__device__ __forceinline__ float wave_sum(float v) {
#pragma unroll
    for (int o = 1; o < 64; o <<= 1) v += xshfl_xor(v, o);
    return v;
}
__device__ __forceinline__ float fsigmoid(float x) { return __builtin_amdgcn_rcpf(1.f + __expf(-x)); }
__device__ __forceinline__ float sin_rad(float y) { return __builtin_amdgcn_sinf(__builtin_amdgcn_fractf(y * 0.15915494309189535f)); }
#define LDS_WAIT() asm volatile("s_waitcnt lgkmcnt(0)" ::: "memory")
#define LBAR() do { asm volatile("s_waitcnt lgkmcnt(0)" ::: "memory"); __builtin_amdgcn_s_barrier(); asm volatile("" ::: "memory"); } while (0)

namespace pg8 {
#define PG8_LAS __attribute__((address_space(3)))
constexpr int BM = 256, BK = 64, HALF = 128, HTB = HALF * BK * 2, STAGE_BYTES = 8 * HTB, NXCD = 8, WGM = 8;
__host__ __device__ __forceinline__ int lds_byte(int r, int c) { const int st = (r >> 4) * 2 + (c >> 5), rr = r & 15, cc = c & 31, ob = rr * 64 + cc * 2; return st * 1024 + (ob ^ (((ob >> 9) & 1) << 5)); }
__host__ __device__ __forceinline__ void stage_rc(int b, int& R, int& C) { const int st = b / 1024, sb = b % 1024, swz = sb ^ (((sb >> 9) & 1) << 5); R = (st >> 1) * 16 + swz / 64; C = (st & 1) * 32 + (swz % 64) / 2; }
__host__ __device__ __forceinline__ int perm32(int rho) { const int n = rho >> 4, i = rho & 15; return 8 * (i >> 2) + 4 * n + (i & 3); }
struct Unit { int pm, pn; };
struct Gemm { const bf16_t* A; const bf16_t* Bt; int K; int a_tile_rows; int a_row0; int a_half_rows; int amode; int span; };
struct StaticOrder {
    int nM, nN, nwg, G, c;
    __host__ __device__ void init(int nM_, int nN_, int G_, int c_) { nM = nM_; nN = nN_; nwg = nM * nN; G = G_; c = c_; }
    __host__ __device__ bool next(int i, Unit& u) const {
        const long L = (long)i * G + c; if (L >= nwg) return false;
        int wgid = (int)L; { const int q = nwg / NXCD, r = nwg % NXCD, xcd = wgid % NXCD, off = wgid / NXCD; wgid = (xcd < r ? xcd * (q + 1) : r * (q + 1) + (xcd - r) * q) + off; }
        const int nig = WGM * nN, gid = wgid / nig, fm = gid * WGM, gsz = (nM - fm) < WGM ? (nM - fm) : WGM;
        u.pm = fm + ((wgid % nig) % gsz); u.pn = (wgid % nig) / gsz; return true;
    }
};
__device__ __forceinline__ unsigned cvt_pk_bf16(float lo, float hi) { unsigned r; asm volatile("v_cvt_pk_bf16_f32 %0, %1, %2" : "=v"(r) : "v"(lo), "v"(hi)); return r; }

template <class Epi, class Sched, bool ALIGN_EPI = false, bool SP2 = false>
__device__ __forceinline__ void gemm_phase(PG8_LAS unsigned char* lds, const Gemm g, const Sched& S, const Epi& E) {
    const int tid = opaque_tid(), wid = __builtin_amdgcn_readfirstlane(tid >> 6), lane = tid & 63, wr = wid >> 2, wc = wid & 3, fr = lane & 15, fq = lane >> 4;
    const int K = g.K, nt = K / BK;
    unsigned voffA[2], voffB[2];
#pragma unroll
    for (int i = 0; i < 2; ++i) { int R, C; stage_rc(tid * 16 + i * 8192, R, C); const int Rb = Epi::PERM ? ((R & ~31) + perm32(R & 31)) : R;
        const int Ra = g.amode ? (g.span * (R >> 6) + 8 * (R & 15) + ((R >> 4) & 3)) : R;
        voffA[i] = (unsigned)(Ra * K + C) * 2u; voffB[i] = (unsigned)(Rb * K + C) * 2u; }
    const size_t kstep = (size_t)(BK * 2);
    const size_t hstepB = (size_t)HALF * K * 2;
    const size_t hstepA = (size_t)g.a_half_rows * K * 2;
    const size_t tstepB = 2 * hstepB;
    const unsigned ldsw = (unsigned)wid * 1024u;
    const int aoff = lds_byte(wr * 64 + fr, fq * 8), boff = lds_byte(wc * 32 + fr, fq * 8);
#define PG8_ABASE(pm) ((const char*)g.A + ((long)(pm) * g.a_tile_rows + g.a_row0) * (long)K * 2)
#define PG8_SA(b, h) (((b) * 2 + (h)) * HTB)
#define PG8_SB(b, h) ((4 + (b) * 2 + (h)) * HTB)
#define PG8_STAGE(bufoff, gbase, voff) do { _Pragma("unroll") for (int _i = 0; _i < 2; ++_i) \
        __builtin_amdgcn_global_load_lds((const unsigned*)((const char*)(gbase) + (voff)[_i]), (PG8_LAS unsigned*)(lds + (bufoff) + ldsw + _i * 8192), 16, 0, 0); } while (0)
#define PG8_LDA(dst, b, h) do { _Pragma("unroll") for (int m = 0; m < 4; ++m) _Pragma("unroll") for (int k = 0; k < 2; ++k) dst[m][k] = *(const PG8_LAS bf16x8*)(lds + PG8_SA(b, h) + aoff + m * 2048 + k * 1024); } while (0)
#define PG8_LDB(dst, b, h) do { _Pragma("unroll") for (int n = 0; n < 2; ++n) _Pragma("unroll") for (int k = 0; k < 2; ++k) dst[n][k] = *(const PG8_LAS bf16x8*)(lds + PG8_SB(b, h) + boff + n * 2048 + k * 1024); } while (0)
#define PG8_MMA(ai, bj, At, Bt) do { __builtin_amdgcn_s_setprio(1); _Pragma("unroll") for (int m = 0; m < 4; ++m) _Pragma("unroll") for (int n = 0; n < 2; ++n) _Pragma("unroll") for (int k = 0; k < 2; ++k) \
        acc[ai][bj][m][n] = __builtin_amdgcn_mfma_f32_16x16x32_bf16(Bt[n][k], At[m][k], acc[ai][bj][m][n], 0, 0, 0); __builtin_amdgcn_s_setprio(0); } while (0)
#define PG8_WAIT_V(n) asm volatile("s_waitcnt vmcnt(" #n ")" ::: "memory")
#define PG8_WAIT_L(n) asm volatile("s_waitcnt lgkmcnt(" #n ")" ::: "memory")
#define PG8_BAR __builtin_amdgcn_s_barrier()
#define PG8_SCHED __builtin_amdgcn_sched_barrier(0)
    Unit cur, nxt; int ui = 0;
    if (!S.next(0, cur)) return;
    f32x4 acc[2][2][4][2];
#pragma unroll
    for (int a = 0; a < 2; ++a)
#pragma unroll
        for (int b = 0; b < 2; ++b)
#pragma unroll
            for (int m = 0; m < 4; ++m)
#pragma unroll
                for (int n = 0; n < 2; ++n) acc[a][b][m][n] = (f32x4){0.f, 0.f, 0.f, 0.f};
    bf16x8 At[4][2], B0[2][2], B1[2][2];
    const char* cA = PG8_ABASE(cur.pm); const char* cB = (const char*)g.Bt + (size_t)cur.pn * tstepB;
    if constexpr (SP2) {
        PG8_STAGE(PG8_SB(0, 0), cB, voffB); PG8_STAGE(PG8_SB(0, 1), cB + hstepB, voffB); PG8_STAGE(PG8_SA(0, 0), cA, voffA); PG8_STAGE(PG8_SA(0, 1), cA + hstepA, voffA);
        if (wr == 1) PG8_BAR;
        PG8_WAIT_V(2); PG8_BAR;
        PG8_STAGE(PG8_SB(1, 0), cB + kstep, voffB); PG8_STAGE(PG8_SA(1, 0), cA + kstep, voffA); PG8_STAGE(PG8_SB(1, 1), cB + hstepB + kstep, voffB);
        PG8_WAIT_V(6); PG8_BAR;
    } else {
        PG8_STAGE(PG8_SB(0, 0), cB, voffB); PG8_STAGE(PG8_SA(0, 0), cA, voffA); PG8_STAGE(PG8_SB(0, 1), cB + hstepB, voffB); PG8_STAGE(PG8_SA(0, 1), cA + hstepA, voffA);
        if (wr == 1) PG8_BAR;
        PG8_WAIT_V(4); PG8_BAR;
        PG8_STAGE(PG8_SB(1, 0), cB + kstep, voffB); PG8_STAGE(PG8_SA(1, 0), cA + kstep, voffA); PG8_STAGE(PG8_SB(1, 1), cB + hstepB + kstep, voffB);
        PG8_WAIT_V(6); PG8_BAR;
    }
    for (;;) {
        const bool has_next = S.next(ui + 1, nxt);
        const char* nA = has_next ? PG8_ABASE(nxt.pm) : cA; const char* nB = has_next ? (const char*)g.Bt + (size_t)nxt.pn * tstepB : cB;
        for (int t = 0; t < nt; t += 2) {
            const bool last = (t == nt - 2);
            const char* a1 = cA + (size_t)(t + 1) * kstep;
            const char* a2 = last ? nA : cA + (size_t)(t + 2) * kstep; const char* b2 = last ? nB : cB + (size_t)(t + 2) * kstep;
            const char* a3 = a2 + kstep; const char* b3 = b2 + kstep;
            if constexpr (SP2) {
            PG8_LDB(B0, 0, 0); PG8_LDB(B1, 0, 1); PG8_SCHED; PG8_LDA(At, 0, 0); PG8_STAGE(PG8_SA(1, 1), a1 + hstepA, voffA);
            PG8_WAIT_V(8); PG8_WAIT_L(0); PG8_BAR; PG8_MMA(0, 0, At, B0); PG8_MMA(0, 1, At, B1); PG8_BAR; PG8_SCHED;
            PG8_LDA(At, 0, 1); PG8_STAGE(PG8_SB(0, 0), b2, voffB); PG8_STAGE(PG8_SB(0, 1), b2 + hstepB, voffB); PG8_STAGE(PG8_SA(0, 0), a2, voffA);
            PG8_WAIT_V(8); PG8_WAIT_L(0); PG8_BAR; PG8_MMA(1, 0, At, B0); PG8_MMA(1, 1, At, B1); PG8_BAR; PG8_SCHED;
            PG8_LDB(B0, 1, 0); PG8_LDB(B1, 1, 1); PG8_SCHED; PG8_LDA(At, 1, 0); PG8_STAGE(PG8_SA(0, 1), a2 + hstepA, voffA);
            PG8_WAIT_V(8); PG8_WAIT_L(0); PG8_BAR; PG8_MMA(0, 0, At, B0); PG8_MMA(0, 1, At, B1); PG8_BAR; PG8_SCHED;
            PG8_LDA(At, 1, 1); PG8_STAGE(PG8_SB(1, 0), b3, voffB); PG8_STAGE(PG8_SB(1, 1), b3 + hstepB, voffB); PG8_STAGE(PG8_SA(1, 0), a3, voffA);
            PG8_WAIT_V(8); PG8_WAIT_L(0); PG8_BAR; PG8_MMA(1, 0, At, B0); PG8_MMA(1, 1, At, B1); PG8_BAR; PG8_SCHED;
            } else {
            PG8_LDB(B0, 0, 0); PG8_SCHED; PG8_LDA(At, 0, 0); PG8_STAGE(PG8_SA(1, 1), a1 + hstepA, voffA);
            PG8_WAIT_L(8); PG8_BAR; PG8_WAIT_L(0); PG8_MMA(0, 0, At, B0); PG8_BAR; PG8_SCHED;
            PG8_LDB(B1, 0, 1); PG8_STAGE(PG8_SB(0, 0), b2, voffB);
            PG8_BAR; PG8_WAIT_L(0); PG8_MMA(0, 1, At, B1); PG8_BAR;
            PG8_LDA(At, 0, 1); PG8_STAGE(PG8_SA(0, 0), a2, voffA);
            PG8_BAR; PG8_WAIT_L(0); PG8_MMA(1, 0, At, B0); PG8_BAR; PG8_SCHED;
            PG8_STAGE(PG8_SB(0, 1), b2 + hstepB, voffB);
            PG8_WAIT_V(6); PG8_BAR; PG8_MMA(1, 1, At, B1); PG8_BAR;
            PG8_LDB(B0, 1, 0); PG8_SCHED; PG8_LDA(At, 1, 0); PG8_STAGE(PG8_SA(0, 1), a2 + hstepA, voffA);
            PG8_WAIT_L(8); PG8_BAR; PG8_WAIT_L(0); PG8_MMA(0, 0, At, B0); PG8_BAR; PG8_SCHED;
            PG8_LDB(B1, 1, 1); PG8_STAGE(PG8_SB(1, 0), b3, voffB);
            PG8_BAR; PG8_WAIT_L(0); PG8_MMA(0, 1, At, B1); PG8_BAR;
            PG8_LDA(At, 1, 1); PG8_STAGE(PG8_SA(1, 0), a3, voffA);
            PG8_BAR; PG8_WAIT_L(0); PG8_MMA(1, 0, At, B0); PG8_BAR; PG8_SCHED;
            PG8_STAGE(PG8_SB(1, 1), b3 + hstepB, voffB);
            PG8_WAIT_V(6); PG8_BAR; PG8_MMA(1, 1, At, B1); PG8_BAR;
            }
        }
        if constexpr (ALIGN_EPI) { if (wr == 0) PG8_BAR; }
        E(acc, cur, wr, wc, fr, fq);
        if (!has_next) break;
#pragma unroll
        for (int a = 0; a < 2; ++a)
#pragma unroll
            for (int b = 0; b < 2; ++b)
#pragma unroll
                for (int m = 0; m < 4; ++m)
#pragma unroll
                    for (int n = 0; n < 2; ++n) acc[a][b][m][n] = (f32x4){0.f, 0.f, 0.f, 0.f};
        cur = nxt; cA = nA; cB = nB; ++ui;
        if constexpr (ALIGN_EPI) { if (wr == 1) PG8_BAR; }
    }
    PG8_WAIT_V(0);
    if constexpr (!ALIGN_EPI) { if (wr == 0) PG8_BAR; }
    PG8_BAR;
#undef PG8_ABASE
#undef PG8_SA
#undef PG8_SB
#undef PG8_STAGE
#undef PG8_LDA
#undef PG8_LDB
#undef PG8_MMA
#undef PG8_WAIT_V
#undef PG8_WAIT_L
#undef PG8_BAR
#undef PG8_SCHED
}

struct EpiG1 {
    static constexpr bool PERM = true;
    bf16_t* HX; bf16_t* QKVO;
    __device__ __forceinline__ void operator()(f32x4 (&acc)[2][2][4][2], const Unit& u, int wr_, int wc_, int fr_, int fq_) const {
        const int tid_e = opaque_tid(), wid_e = __builtin_amdgcn_readfirstlane(tid_e >> 6), wr = wid_e >> 2, wc = wid_e & 3, fr = tid_e & 15, fq = (tid_e & 63) >> 4; (void)wr_; (void)wc_; (void)fr_; (void)fq_;
        const int tok0 = u.pm * 256 + wr * 128 + fr * 8;
        if (u.pn < 6) {
            bf16_t* T = HX + (size_t)(u.pn >> 1) * HXN;
            size_t sbase; int S, s;
            if (tok0 < MPR) { S = 8192; const int b = tok0 >> 13; s = tok0 & 8191; sbase = (size_t)b * 512 * 8192; }
            else { S = 4096; const int t2 = tok0 - MPR; const int b = t2 >> 12; s = t2 & 4095; sbase = (size_t)MPR * 512 + (size_t)b * 512 * 4096; }
            const int c0 = (u.pn & 1) * 256 + wc * 32 + 8 * fq;
#pragma unroll
            for (int bj = 0; bj < 2; ++bj)
#pragma unroll
                for (int n = 0; n < 2; ++n)
#pragma unroll
                    for (int e = 0; e < 4; ++e) {
                        const int c = c0 + bj * 128 + 4 * n + e;
                        u32x4 w;
                        w.x = cvt_pk_bf16(acc[0][bj][0][n][e], acc[0][bj][1][n][e]); w.y = cvt_pk_bf16(acc[0][bj][2][n][e], acc[0][bj][3][n][e]);
                        w.z = cvt_pk_bf16(acc[1][bj][0][n][e], acc[1][bj][1][n][e]); w.w = cvt_pk_bf16(acc[1][bj][2][n][e], acc[1][bj][3][n][e]);
                        *(u32x4*)(T + sbase + (size_t)c * S + s) = w;
                        if (e == 3) asm volatile("" ::: "memory");
                    }
        } else {
            const int cq0 = (u.pn - 6) * 256 + wc * 32 + 8 * fq;
            const bool sg = (u.pn >= 12);
#pragma unroll
            for (int ai = 0; ai < 2; ++ai)
#pragma unroll
                for (int m = 0; m < 4; ++m) {
                    bf16_t* rowp = QKVO + (size_t)(tok0 + ai * 4 + m) * 2048 + cq0;
#pragma unroll
                    for (int bj = 0; bj < 2; ++bj) {
                        f32x4 v0 = acc[ai][bj][m][0], v1 = acc[ai][bj][m][1];
                        if (sg) {
#pragma unroll
                            for (int e = 0; e < 4; ++e) { v0[e] = fsigmoid(v0[e]); v1[e] = fsigmoid(v1[e]); }
                        }
                        u32x4 w; w.x = cvt_pk_bf16(v0[0], v0[1]); w.y = cvt_pk_bf16(v0[2], v0[3]); w.z = cvt_pk_bf16(v1[0], v1[1]); w.w = cvt_pk_bf16(v1[2], v1[3]);
                        *(u32x4*)(rowp + bj * 128) = w;
                    }
                    asm volatile("" ::: "memory");
                }
        }
    }
};
struct EpiG2 {
    static constexpr bool PERM = true;
    const float* xp; const float* xs; float* out; const float* g2; bf16_t* H2U; float* SS;
    __device__ __forceinline__ void operator()(f32x4 (&acc)[2][2][4][2], const Unit& u, int wr_, int wc_, int fr_, int fq_) const {
        const int tid_e = opaque_tid(), wid_e = __builtin_amdgcn_readfirstlane(tid_e >> 6), wr = wid_e >> 2, wc = wid_e & 3, fr = tid_e & 15, fq = (tid_e & 63) >> 4; (void)wr_; (void)wc_; (void)fr_; (void)fq_;
        const int row0 = u.pm * 256 + wr * 64 + fr, col0 = u.pn * 256 + wc * 32 + 8 * fq;
        f32x4 gv[2][2];
#pragma unroll
        for (int bj = 0; bj < 2; ++bj)
#pragma unroll
            for (int n = 0; n < 2; ++n) gv[bj][n] = *(const f32x4*)(g2 + col0 + bj * 128 + 4 * n);
#pragma unroll
        for (int ai = 0; ai < 2; ++ai) {
            f32x4 xr4[4][2][2];
#pragma unroll
            for (int m = 0; m < 4; ++m) {
                const int row = row0 + ai * 128 + m * 16;
                const float* xr = (row < MPR ? xp + (size_t)row * DM : xs + (size_t)(row - MPR) * DM) + col0;
#pragma unroll
                for (int bj = 0; bj < 2; ++bj) { xr4[m][bj][0] = *(const f32x4*)(xr + bj * 128); xr4[m][bj][1] = *(const f32x4*)(xr + bj * 128 + 4); }
            }
#pragma unroll
            for (int m = 0; m < 4; ++m) {
                const int row = row0 + ai * 128 + m * 16;
                float* o = out + (size_t)row * DM + col0;
                bf16_t* hb = H2U + (size_t)row * DM + col0;
                float s = 0.f;
#pragma unroll
                for (int bj = 0; bj < 2; ++bj) {
                    const f32x4 v0 = xr4[m][bj][0] + acc[ai][bj][m][0], v1 = xr4[m][bj][1] + acc[ai][bj][m][1];
                    *(f32x4*)(o + bj * 128) = v0; *(f32x4*)(o + bj * 128 + 4) = v1;
                    s += (v0.x * v0.x + v0.y * v0.y) + (v0.z * v0.z + v0.w * v0.w) + (v1.x * v1.x + v1.y * v1.y) + (v1.z * v1.z + v1.w * v1.w);
                    const f32x4 h0 = v0 * gv[bj][0], h1 = v1 * gv[bj][1];
                    u32x4 w; w.x = cvt_pk_bf16(h0[0], h0[1]); w.y = cvt_pk_bf16(h0[2], h0[3]); w.z = cvt_pk_bf16(h1[0], h1[1]); w.w = cvt_pk_bf16(h1[2], h1[3]);
                    *(u32x4*)(hb + bj * 128) = w;
                }
                s += xshfl_xor(s, 16); s += xshfl_xor(s, 32);
                if (fq == 0) atomicAdd(SS + row, s);
            }
        }
    }
};
struct EpiG4 {
    static constexpr bool PERM = false;
    float* out;
    __device__ __forceinline__ void operator()(f32x4 (&acc)[2][2][4][2], const Unit& u, int wr_, int wc_, int fr_, int fq_) const {
        const int tid_e = opaque_tid(), wid_e = __builtin_amdgcn_readfirstlane(tid_e >> 6), wr = wid_e >> 2, wc = wid_e & 3, fr = tid_e & 15, fq = (tid_e & 63) >> 4; (void)wr_; (void)wc_; (void)fr_; (void)fq_;
        const int row0 = u.pm * 256 + wr * 64 + fr, col0 = u.pn * 256 + wc * 32 + 4 * fq;
#pragma unroll
        for (int ai = 0; ai < 2; ++ai) {
            f32x4 xr4[4][2][2];
#pragma unroll
            for (int m = 0; m < 4; ++m) {
                const float* o = out + (size_t)(row0 + ai * 128 + m * 16) * DM + col0;
#pragma unroll
                for (int bj = 0; bj < 2; ++bj)
#pragma unroll
                    for (int n = 0; n < 2; ++n) xr4[m][bj][n] = *(const f32x4*)(o + bj * 128 + n * 16);
            }
#pragma unroll
            for (int m = 0; m < 4; ++m) {
                float* o = out + (size_t)(row0 + ai * 128 + m * 16) * DM + col0;
#pragma unroll
                for (int bj = 0; bj < 2; ++bj)
#pragma unroll
                    for (int n = 0; n < 2; ++n) *(f32x4*)(o + bj * 128 + n * 16) = xr4[m][bj][n] + acc[ai][bj][m][n];
            }
        }
    }
};
__device__ __forceinline__ float dpp_row_shr1(float x) { return __builtin_bit_cast(float, __builtin_amdgcn_update_dpp(0, __builtin_bit_cast(int, x), 0x111, 0xf, 0xf, false)); }
__device__ __forceinline__ float dpp_row_shl1(float x) { return __builtin_bit_cast(float, __builtin_amdgcn_update_dpp(0, __builtin_bit_cast(int, x), 0x101, 0xf, 0xf, false)); }
__device__ __forceinline__ bool seq_start(int g) { return g < MPR ? ((g & 8191) == 0) : ((g & 4095) == 0); }
struct EpiG3 {
    static constexpr bool PERM = true;
    const float* cw; const float* cb; bf16_t* ACT; const float* SS;
    __device__ __forceinline__ void operator()(f32x4 (&acc)[2][2][4][2], const Unit& u, int wr_, int wc_, int fr_, int fq_) const {
        const int tid_e = opaque_tid(), wid_e = __builtin_amdgcn_readfirstlane(tid_e >> 6), wr = wid_e >> 2, wc = wid_e & 3, fr = tid_e & 15, fq = (tid_e & 63) >> 4; (void)wr_; (void)wc_; (void)fr_; (void)fq_;
        const int gbase = u.pm * 252 + wr * 126 + 8 * fr - 1;
        const int ch0 = u.pn * 128 + wc * 32 + 8 * fq;
        {
            const float* sp = SS + gbase;
            float rs[8];
#pragma unroll
            for (int i = 0; i < 8; ++i) rs[i] = sp[i];
#pragma unroll
            for (int i = 0; i < 8; ++i) {
                const float r = rsqrtf(rs[i] * (1.f / DM) + 1e-6f);
#pragma unroll
                for (int bj = 0; bj < 2; ++bj)
#pragma unroll
                    for (int n = 0; n < 2; ++n) acc[i >> 2][bj][i & 3][n] = acc[i >> 2][bj][i & 3][n] * r;
            }
            asm volatile("" ::: "memory");
        }
        f32x4 WV[2][4], WG[2][4];
#pragma unroll
        for (int n = 0; n < 2; ++n) {
#pragma unroll
            for (int r = 0; r < 3; ++r) { WV[n][r] = *(const f32x4*)(cw + r * FF2 + ch0 + 4 * n); WG[n][r] = *(const f32x4*)(cw + r * FF2 + FF + ch0 + 4 * n); }
            WV[n][3] = *(const f32x4*)(cb + ch0 + 4 * n); WG[n][3] = *(const f32x4*)(cb + FF + ch0 + 4 * n);
        }
        float dep = 0.f;
#pragma unroll
        for (int n = 0; n < 2; ++n)
#pragma unroll
            for (int e = 0; e < 4; ++e) {
                const float wv0 = WV[n][0][e], wv1 = WV[n][1][e], wv2 = WV[n][2][e], bv = WV[n][3][e];
                const float wg0 = WG[n][0][e], wg1 = WG[n][1][e], wg2 = WG[n][2][e], bg = WG[n][3][e];
                float s0 = acc[1][0][3][n][e], s1 = acc[0][0][0][n][e], s2 = acc[1][1][3][n][e], s3 = acc[0][1][0][n][e];
                asm volatile("" : "+v"(s0), "+v"(s1), "+v"(s2), "+v"(s3) : "v"(dep));
                const float Vp = dpp_row_shr1(s0), Vn = dpp_row_shl1(s1), Gp = dpp_row_shr1(s2), Gn = dpp_row_shl1(s3);
                float pv = Vp, pg = Gp;
#pragma unroll
                for (int i = 0; i < 8; ++i) {
                    const float cvv = acc[i >> 2][0][i & 3][n][e], cgg = acc[i >> 2][1][i & 3][n][e];
                    const float nv = (i == 7) ? Vn : acc[(i + 1 > 7 ? 7 : i + 1) >> 2][0][(i + 1 > 7 ? 7 : i + 1) & 3][n][e];
                    const float ng = (i == 7) ? Gn : acc[(i + 1 > 7 ? 7 : i + 1) >> 2][1][(i + 1 > 7 ? 7 : i + 1) & 3][n][e];
                    const bool sti = seq_start(gbase + i), eni = seq_start(gbase + i + 1);
                    const float cv = wv1 * cvv + bv + (sti ? 0.f : wv0 * pv) + (eni ? 0.f : wv2 * nv);
                    const float cgt = wg1 * cgg + bg + (sti ? 0.f : wg0 * pg) + (eni ? 0.f : wg2 * ng);
                    acc[i >> 2][0][i & 3][n][e] = cv * cgt * fsigmoid(cgt);
                    pv = cvv; pg = cgg;
                }
                dep = acc[1][0][3][n][e];
            }
#pragma unroll
        for (int i = 0; i < 8; ++i) {
            const int li = 8 * fr + i, g = gbase + i;
            if (li >= 1 && li <= 126 && g < MTOK) {
                const f32x4 v0 = acc[i >> 2][0][i & 3][0], v1 = acc[i >> 2][0][i & 3][1];
                u32x4 w; w.x = cvt_pk_bf16(v0[0], v0[1]); w.y = cvt_pk_bf16(v0[2], v0[3]); w.z = cvt_pk_bf16(v1[0], v1[1]); w.w = cvt_pk_bf16(v1[2], v1[3]);
                *(u32x4*)(ACT + (size_t)g * FF + ch0) = w;
            }
        }
    }
};
}

__device__ __forceinline__ int padidx(int p) { return p + ((p >> 6) << 2); }
template <int NN> __device__ __forceinline__ int padidxN(int p) { return NN == 8192 ? p + ((p >> 5) << 1) : p + ((p >> 6) << 2); }
__device__ __forceinline__ float cos16(int k) { switch (k & 7) { case 0: return 1.f; case 1: return 0.92387953251f; case 2: return 0.70710678119f; case 3: return 0.38268343237f; case 4: return 0.f; case 5: return -0.38268343237f; case 6: return -0.70710678119f; default: return -0.92387953251f; } }
__device__ __forceinline__ float sin16(int k) { switch (k & 7) { case 0: return 0.f; case 1: return 0.38268343237f; case 2: return 0.70710678119f; case 3: return 0.92387953251f; case 4: return 1.f; case 5: return 0.92387953251f; case 6: return 0.70710678119f; default: return 0.38268343237f; } }
template <int R> __device__ __forceinline__ constexpr int bitrev_r(int i) { int r = 0; for (int b = 1, c = R >> 1; b < R; b <<= 1, c >>= 1) if (i & b) r |= c; return r; }
typedef f32x2 cplx;
__device__ __forceinline__ cplx cmul(cplx a, cplx w) { const cplx sw = __builtin_shufflevector(a, a, 1, 0); return a * (cplx){w.x, w.x} + sw * (cplx){-w.y, w.y}; }
__device__ __forceinline__ cplx cmulc(cplx a, cplx w) { const cplx sw = __builtin_shufflevector(a, a, 1, 0); return a * (cplx){w.x, w.x} + sw * (cplx){w.y, -w.y}; }
template <int R, bool ZH> __device__ __forceinline__ void reg_fft_fwd(cplx (&x)[R]) {
#pragma unroll
    for (int half = R / 2; half >= 1; half >>= 1) {
#pragma unroll
        for (int i = 0; i < R; ++i) {
            if ((i & half) == 0) {
                const int j = i + half, k16 = (i & (half - 1)) * 8 / half;
                const cplx a = x[i], b = x[j];
                cplx d;
                if (ZH && half == R / 2) { d = a; } else { x[i] = a + b; d = a - b; }
                if (k16 == 0) x[j] = d;
                else if (k16 == 4) { cplx t; t.x = d.y; t.y = -d.x; x[j] = t; }
                else x[j] = cmulc(d, (cplx){cos16(k16), sin16(k16)});
            }
        }
    }
}
template <int R, bool OH> __device__ __forceinline__ void reg_fft_inv(cplx (&x)[R]) {
#pragma unroll
    for (int half = 1; half < R; half <<= 1) {
#pragma unroll
        for (int i = 0; i < R; ++i) {
            if ((i & half) == 0) {
                const int j = i + half, k16 = (i & (half - 1)) * 8 / half;
                const cplx a = x[i]; cplx b = x[j];
                if (k16 == 0) {}
                else if (k16 == 4) { cplx t; t.x = -b.y; t.y = b.x; b = t; }
                else b = cmul(b, (cplx){cos16(k16), sin16(k16)});
                x[i] = a + b;
                if (!(OH && half == R / 2)) x[j] = a - b;
            }
        }
    }
}
template <int R> __device__ __forceinline__ void tw_powers(cplx w1, cplx (&P)[R]) {
    P[0] = (cplx){1.f, 0.f}; P[1] = w1;
    if (R > 2) { P[2] = cmul(w1, w1); P[3] = cmul(P[2], w1); }
    if (R > 4) { P[4] = cmul(P[2], P[2]); P[5] = cmul(P[4], w1); P[6] = cmul(P[3], P[3]); P[7] = cmul(P[4], P[3]); }
    if (R > 8) { P[8] = cmul(P[4], P[4]); P[9] = cmul(P[8], w1); P[10] = cmul(P[5], P[5]); P[11] = cmul(P[8], P[3]); P[12] = cmul(P[6], P[6]); P[13] = cmul(P[8], P[5]); P[14] = cmul(P[7], P[7]); P[15] = cmul(P[8], P[7]); }
}
template <int R, bool INV, bool NOTW, bool HALF, int MBLK, int NN, int NZ = 1> __device__ __forceinline__ void fft_pass(LAS cplx* Z, const LAS cplx* TW) {
    constexpr int s = MBLK / R;
    constexpr int ZSTR = NN + NN / 16;
#define FOFF(k) (NN == 8192 ? ((k) * s + ((((k) * s) >> 5) << 1)) : ((k) * s + ((((k) * s) >> 6) << 2)))
    constexpr int TSH = 16384 / MBLK;
    for (int t = opaque_tid(); t < NN / R; t += 512) {
        const int j = t % s, b0 = (t / s) * MBLK + j;
        LAS cplx* zp = Z + padidxN<NN>(b0);
        cplx x[NZ][R]; cplx P[R];
        if (!INV) {
#pragma unroll
            for (int z = 0; z < NZ; ++z) {
#pragma unroll
                for (int k = 0; k < (HALF ? R / 2 : R); ++k) x[z][k] = zp[z * ZSTR + FOFF(k)];
                if (HALF) {
#pragma unroll
                    for (int k = R / 2; k < R; ++k) x[z][k] = (cplx){0.f, 0.f};
                }
            }
            if (!NOTW) tw_powers<R>(TW[j * TSH], P);
#pragma unroll
            for (int z = 0; z < NZ; ++z) {
                reg_fft_fwd<R, HALF>(x[z]);
#pragma unroll
                for (int i = 0; i < R; ++i) { const int q = bitrev_r<R>(i); zp[z * ZSTR + FOFF(q)] = (NOTW || q == 0) ? x[z][i] : cmulc(x[z][i], P[q]); }
            }
        } else {
#pragma unroll
            for (int z = 0; z < NZ; ++z)
#pragma unroll
                for (int i = 0; i < R; ++i) { const int q = bitrev_r<R>(i); x[z][i] = zp[z * ZSTR + FOFF(q)]; }
            if (!NOTW) tw_powers<R>(TW[j * TSH], P);
#pragma unroll
            for (int z = 0; z < NZ; ++z) {
                if (!NOTW) {
#pragma unroll
                    for (int i = 0; i < R; ++i) { const int q = bitrev_r<R>(i); if (q != 0) x[z][i] = cmul(x[z][i], P[q]); }
                }
                reg_fft_inv<R, HALF>(x[z]);
#pragma unroll
                for (int k = 0; k < (HALF ? R / 2 : R); ++k) zp[z * ZSTR + FOFF(k)] = x[z][k];
            }
        }
    }
    LBAR();
}
template <int NN> __device__ __forceinline__ void fft_fwd_full(LAS cplx* Z, const LAS cplx* TW) {
    fft_pass<16, false, false, false, NN, NN>(Z, TW); fft_pass<16, false, false, false, NN / 16, NN>(Z, TW); fft_pass<16, false, false, false, NN / 256, NN>(Z, TW);
    fft_pass<NN / 4096, false, true, false, NN / 4096, NN>(Z, TW);
}
template <int NN, int NZ> __device__ __forceinline__ void fft_conv(LAS cplx* Z, const LAS cplx* TW, const cplx* const (&Kp)[NZ]) {
    constexpr int R4 = NN / 4096, NIT = NN / R4 / 512, ZSTR = NN + NN / 16;
    const int tid = opaque_tid();
    f32x4 kk[NZ][NIT][R4 / 2];
#pragma unroll
    for (int z = 0; z < NZ; ++z)
#pragma unroll
        for (int i = 0; i < NIT; ++i)
#pragma unroll
            for (int h = 0; h < R4 / 2; ++h) kk[z][i][h] = *(const f32x4*)(Kp[z] + R4 * (tid + 512 * i) + 2 * h);
    fft_pass<16, false, false, true, NN, NN, NZ>(Z, TW); fft_pass<16, false, false, false, NN / 16, NN, NZ>(Z, TW); fft_pass<16, false, false, false, NN / 256, NN, NZ>(Z, TW);
#pragma unroll
    for (int z = 0; z < NZ; ++z)
#pragma unroll
        for (int i = 0; i < NIT; ++i) {
            LAS cplx* zp = Z + z * ZSTR + padidxN<NN>(R4 * (tid + 512 * i));
            cplx x[R4], kc[R4];
#pragma unroll
            for (int h = 0; h < R4 / 2; ++h) { const f32x4 v = *(const LAS f32x4*)(zp + 2 * h); x[2 * h] = (cplx){v.x, v.y}; x[2 * h + 1] = (cplx){v.z, v.w}; kc[2 * h] = (cplx){kk[z][i][h].x, kk[z][i][h].y}; kc[2 * h + 1] = (cplx){kk[z][i][h].z, kk[z][i][h].w}; }
            reg_fft_fwd<R4, false>(x);
#pragma unroll
            for (int q = 0; q < R4; ++q) x[q] = cmul(x[q], kc[bitrev_r<R4>(q)]);
            reg_fft_inv<R4, false>(x);
#pragma unroll
            for (int h = 0; h < R4 / 2; ++h) { f32x4 v; v.x = x[2 * h].x; v.y = x[2 * h].y; v.z = x[2 * h + 1].x; v.w = x[2 * h + 1].y; *(LAS f32x4*)(zp + 2 * h) = v; }
        }
    LBAR();
    fft_pass<16, true, false, false, NN / 256, NN, NZ>(Z, TW); fft_pass<16, true, false, false, NN / 16, NN, NZ>(Z, TW); fft_pass<16, true, false, true, NN, NN, NZ>(Z, TW);
}
__device__ __forceinline__ void tw_init(LAS cplx* TW) {
    for (int j = opaque_tid(); j < 1024; j += 512) { const float r = (float)j * (1.0f / 16384.0f); cplx w; w.x = __builtin_amdgcn_cosf(r); w.y = __builtin_amdgcn_sinf(r); TW[j] = w; }
}

constexpr int FFT_LDS = (16384 + 1024) * 8;
constexpr int FFT_AUX = FFT_LDS;
constexpr int FFT_TW = FFT_LDS + 544;

__device__ __forceinline__ void taps_item(LAS unsigned char* lds, int it, const float* HID, const float* w3, unsigned char* outb) {
    const int tid = opaque_tid();
    int lsel, tt, ct;
    if (it < 512) { lsel = 0; tt = it >> 5; ct = it & 31; } else { lsel = 1; const int r = it - 512; tt = r >> 5; ct = r & 31; }
    const int L = lsel ? 4096 : 8192, t = tt * 512 + tid;
    LAS float* W = (LAS float*)lds;
    LBAR();
    for (int i = tid; i < 4096; i += 512) { const int j = i >> 6, c = i & 63; W[c * 64 + j] = w3[(size_t)j * 2048 + ct * 64 + c]; }
    f32x4 h[16];
    const f32x4* hr = (const f32x4*)(HID + ((lsel ? (size_t)8192 : 0) + t) * 64);
#pragma unroll
    for (int q = 0; q < 16; ++q) h[q] = hr[q];
    LBAR();
    float* dst = (float*)(outb + OUT_TAPS) + (lsel ? (size_t)2048 * 8192 : 0) + (size_t)(ct * 64) * L + t;
#pragma unroll 2
    for (int c = 0; c < 64; ++c) {
        float d0 = 0.f, d1 = 0.f;
#pragma unroll
        for (int q = 0; q < 16; ++q) { const f32x4 w = *(const LAS f32x4*)(W + c * 64 + 4 * q); d0 += h[q].x * w.x + h[q].z * w.z; d1 += h[q].y * w.y + h[q].w * w.w; }
        dst[(size_t)c * L] = d0 + d1;
    }
}

__device__ __forceinline__ void spectrum_item(LAS unsigned char* lds, int item, const float* hy_bias, unsigned char* outb) {
    const int tid = opaque_tid();
    const int lsel = item >> 10, order = (item >> 9) & 1, ch = item & 511;
    const int L = lsel ? 4096 : 8192, N = 2 * L;
#define PADL(p_) (lsel ? padidxN<8192>(p_) : padidxN<16384>(p_))
    LAS f32x2* Z = (LAS f32x2*)lds; LAS cplx* TW = (LAS cplx*)(lds + FFT_TW); tw_init(TW);
    LAS float* aux = (LAS float*)(lds + FFT_AUX);
    const float* TF = (const float*)(outb + OUT_TAPS) + (lsel ? (size_t)2048 * 8192 : 0) + (size_t)(order * 512 + ch) * L;
    const float* TB = TF + (size_t)1024 * L;
    LBAR();
    const float delta = 3.0701134573253945f + (float)ch * ((15.350567286626973f - 3.0701134573253945f) / 511.0f);
    float ss = 0.f;
    for (int t0 = tid; t0 < L; t0 += 8 * 512) {
        float tf[8], tb[8];
#pragma unroll
        for (int i = 0; i < 8; ++i) { tf[i] = TF[t0 + 512 * i]; tb[i] = TB[t0 + 512 * i]; }
#pragma unroll
        for (int i = 0; i < 8; ++i) {
            const int t = t0 + 512 * i;
            const float dec = __expf(-((float)t / (float)(L - 1)) * delta);
            const float hf = tf[i] * dec, hb = tb[i] * dec;
            f32x2 o; o.y = 0.f; o.x = hf; Z[PADL(t)] = o; ss += hf * hf;
            if (t >= 1) { o.x = hb; Z[PADL(N - t)] = o; ss += hb * hb; }
        }
    }
    if (tid == 0) { f32x2 o; o.x = 0.f; o.y = 0.f; Z[PADL(L)] = o; }
    ss = wave_sum(ss);
    if ((tid & 63) == 0) aux[128 + (tid >> 6)] = ss;
    LBAR();
    float tot = 0.f;
#pragma unroll
    for (int w = 0; w < 8; ++w) tot += aux[128 + w];
    const float invN = 1.0f / (float)N;
    const float scale = rsqrtf(tot) * invN;
    for (int p = tid; p < N; p += 512) { f32x2 z = Z[PADL(p)]; z.x *= scale; if (p == 0) z.x += hy_bias[order * 512 + ch] * invN; Z[PADL(p)] = z; }
    LBAR();
    if (lsel) fft_fwd_full<8192>(Z, TW); else fft_fwd_full<16384>(Z, TW);
    f32x2* dst = (f32x2*)(outb + (lsel ? OUT_SPEC1 : OUT_SPEC0)) + (size_t)(order * 512 + ch) * N;
    for (int p = tid; p < N; p += 512) dst[p] = Z[PADL(p)];
    LBAR();
}
#undef PADL

struct Raw8 { u32x4 raw; float left, right; };
__device__ __forceinline__ Raw8 load_raw8(const bf16_t* base, int n0, int L) {
    Raw8 r; r.raw = *(const u32x4*)(base + n0);
    r.left = n0 > 0 ? bf1(base[n0 - 1]) : 0.f; r.right = (n0 + 8 < L) ? bf1(base[n0 + 8]) : 0.f; return r;
}
__device__ __forceinline__ void conv_raw8(const Raw8& r, float w0, float w1, float w2, float b, float (&out)[8]) {
    float x[10]; x[0] = r.left; x[9] = r.right;
    x[1] = bflo(r.raw.x); x[2] = bfhi(r.raw.x); x[3] = bflo(r.raw.y); x[4] = bfhi(r.raw.y); x[5] = bflo(r.raw.z); x[6] = bfhi(r.raw.z); x[7] = bflo(r.raw.w); x[8] = bfhi(r.raw.w);
#pragma unroll
    for (int e = 0; e < 8; ++e) out[e] = w0 * x[e] + w1 * x[e + 1] + w2 * x[e + 2] + b;
}
template <int NN, int NZ> __device__ __forceinline__ void hyena_body(LAS unsigned char* lds, int pair, int ch0, const bf16_t* HX, bf16_t* YH, const float* conv_w, const float* conv_b, const unsigned char* outb) {
    constexpr int L = NN / 2, NIT = L / 8 / 512, lsel = (NN == 8192), ZSTR = NN + NN / 16;
    const int tid = opaque_tid();
    size_t sb[NZ][2];
    const cplx* K1[NZ]; const cplx* K2[NZ];
#pragma unroll
    for (int z = 0; z < NZ; ++z) {
        const int ch = ch0 + z;
#pragma unroll
        for (int bb = 0; bb < 2; ++bb) { const int b = 2 * pair + bb; sb[z][bb] = lsel ? ((size_t)MPR * 512 + ((size_t)b * 512 + ch) * 4096) : (((size_t)b * 512 + ch) * 8192); }
        K1[z] = (const f32x2*)(outb + (lsel ? OUT_SPEC1 : OUT_SPEC0)) + (size_t)ch * NN; K2[z] = K1[z] + (size_t)512 * NN;
    }
    LAS f32x2* Z = (LAS f32x2*)lds; LAS cplx* TW = (LAS cplx*)(lds + FFT_TW);
    const bf16_t* X1 = HX; const bf16_t* X2 = HX + HXN; const bf16_t* XV = HX + 2 * HXN;
    Raw8 rv[NZ][NIT][2], rx[NZ][NIT][2];
#pragma unroll
    for (int z = 0; z < NZ; ++z)
#pragma unroll
        for (int i = 0; i < NIT; ++i)
#pragma unroll
            for (int bb = 0; bb < 2; ++bb) { rv[z][i][bb] = load_raw8(XV + sb[z][bb], 8 * (tid + 512 * i), L); rx[z][i][bb] = load_raw8(X1 + sb[z][bb], 8 * (tid + 512 * i), L); }
    tw_init(TW);
#pragma unroll
    for (int z = 0; z < NZ; ++z) {
        const int ch = ch0 + z;
        const float w0 = conv_w[1024 + ch], w1 = conv_w[2560 + 1024 + ch], w2 = conv_w[2 * 2560 + 1024 + ch], bc = conv_b[1024 + ch];
#pragma unroll
        for (int i = 0; i < NIT; ++i) {
            const int n0 = 8 * (tid + 512 * i); float a[8], c[8];
            conv_raw8(rv[z][i][0], w0, w1, w2, bc, a); conv_raw8(rv[z][i][1], w0, w1, w2, bc, c);
#pragma unroll
            for (int e = 0; e < 4; ++e) { f32x4 o; o.x = a[2 * e]; o.y = c[2 * e]; o.z = a[2 * e + 1]; o.w = c[2 * e + 1]; *(LAS f32x4*)(Z + z * ZSTR + padidxN<NN>(n0) + 2 * e) = o; }
        }
    }
    LBAR();
    fft_conv<NN, NZ>(Z, TW, K1);
#pragma unroll
    for (int z = 0; z < NZ; ++z) {
        const int ch = ch0 + z;
        const float w0 = conv_w[ch], w1 = conv_w[2560 + ch], w2 = conv_w[2 * 2560 + ch], bc = conv_b[ch];
#pragma unroll
        for (int i = 0; i < NIT; ++i) {
            const int n0 = 8 * (tid + 512 * i); float a[8], c[8];
            conv_raw8(rx[z][i][0], w0, w1, w2, bc, a); conv_raw8(rx[z][i][1], w0, w1, w2, bc, c);
#pragma unroll
            for (int e = 0; e < 4; ++e) { LAS f32x4* zp4 = (LAS f32x4*)(Z + z * ZSTR + padidxN<NN>(n0) + 2 * e); const f32x4 y = *zp4; f32x4 o; o.x = a[2 * e] * y.x; o.y = c[2 * e] * y.y; o.z = a[2 * e + 1] * y.z; o.w = c[2 * e + 1] * y.w; *zp4 = o; }
        }
#pragma unroll
        for (int i = 0; i < NIT; ++i)
#pragma unroll
            for (int bb = 0; bb < 2; ++bb) rx[z][i][bb] = load_raw8(X2 + sb[z][bb], 8 * (tid + 512 * i), L);
    }
    LBAR();
    fft_conv<NN, NZ>(Z, TW, K2);
#pragma unroll
    for (int z = 0; z < NZ; ++z) {
        const int ch = ch0 + z;
        const float w0 = conv_w[512 + ch], w1 = conv_w[2560 + 512 + ch], w2 = conv_w[2 * 2560 + 512 + ch], bc = conv_b[512 + ch];
#pragma unroll
        for (int i = 0; i < NIT; ++i) {
            const int n0 = 8 * (tid + 512 * i); float a[8], c[8];
            conv_raw8(rx[z][i][0], w0, w1, w2, bc, a); conv_raw8(rx[z][i][1], w0, w1, w2, bc, c);
            float ya[8], yc[8];
#pragma unroll
            for (int e = 0; e < 4; ++e) { const f32x4 y = *(const LAS f32x4*)(Z + z * ZSTR + padidxN<NN>(n0) + 2 * e); ya[2 * e] = a[2 * e] * y.x; yc[2 * e] = c[2 * e] * y.y; ya[2 * e + 1] = a[2 * e + 1] * y.z; yc[2 * e + 1] = c[2 * e + 1] * y.w; }
            u32x4 wa, wc2;
            wa.x = pk2(ya[0], ya[1]); wa.y = pk2(ya[2], ya[3]); wa.z = pk2(ya[4], ya[5]); wa.w = pk2(ya[6], ya[7]);
            wc2.x = pk2(yc[0], yc[1]); wc2.y = pk2(yc[2], yc[3]); wc2.z = pk2(yc[4], yc[5]); wc2.w = pk2(yc[6], yc[7]);
            *(u32x4*)(YH + sb[z][0] + n0) = wa; *(u32x4*)(YH + sb[z][1] + n0) = wc2;
        }
    }
    LBAR();
}
constexpr int HY_ITEMS = 1024 + 2048;
__device__ __forceinline__ void hyena_item(LAS unsigned char* lds, int item, const bf16_t* HX, bf16_t* YH, const float* conv_w, const float* conv_b, const unsigned char* outb) {
    if (item < 1024) hyena_body<16384, 1>(lds, item >> 9, item & 511, HX, YH, conv_w, conv_b, outb);
    else { const int r = 2 * (item - 1024); hyena_body<8192, 2>(lds, r >> 9, r & 511, HX, YH, conv_w, conv_b, outb); }
}

#define DPPF(oldv, x, ctrl, rmask) __builtin_bit_cast(float, __builtin_amdgcn_update_dpp(__builtin_bit_cast(int, (float)(oldv)), __builtin_bit_cast(int, (x)), (ctrl), (rmask), 0xf, false))
__device__ __forceinline__ float scan_add64(float x) {
    x += DPPF(0.f, x, 0x111, 0xf); x += DPPF(0.f, x, 0x112, 0xf); x += DPPF(0.f, x, 0x114, 0xf); x += DPPF(0.f, x, 0x118, 0xf);
    x += DPPF(0.f, x, 0x142, 0xa); x += DPPF(0.f, x, 0x143, 0xc); return x;
}
__device__ __forceinline__ float scan_max64(float x) {
    const float ninf = -__builtin_inff();
    x = fmaxf(x, DPPF(ninf, x, 0x111, 0xf)); x = fmaxf(x, DPPF(ninf, x, 0x112, 0xf)); x = fmaxf(x, DPPF(ninf, x, 0x114, 0xf)); x = fmaxf(x, DPPF(ninf, x, 0x118, 0xf));
    x = fmaxf(x, DPPF(ninf, x, 0x142, 0xa)); x = fmaxf(x, DPPF(ninf, x, 0x143, 0xc)); return x;
}
constexpr int ML_QS = 0, ML_KS = 17408, ML_KWT = 34816, ML_VT = 53248, ML_SM = 71680, ML_TOK = 80896  , ML_NV = 84992, ML_QN = 85504, ML_ROWS = 85760;
__device__ __forceinline__ void mlstm_item(LAS unsigned char* lds, int item, const bf16_t* QKVO, const bf16_t* QK2, const float* GATES, unsigned char* outb) {
    const int tid = opaque_tid(), lane = tid & 63, wave = tid >> 6, fr = lane & 15, fq = lane >> 4;
    int seq, head, dir, cfull, cend;
    if (item < 64) { const int r = item & 31; seq = r >> 3; head = (r >> 1) & 3; dir = r & 1; cfull = item < 32 ? 64 : 0; cend = item < 32 ? 128 : 64; }
    else { const int r = item - 64; seq = 4 + (r >> 3); head = (r >> 1) & 3; dir = r & 1; cfull = 0; cend = 64; }
    const int S = seq < 4 ? 8192 : 4096, tok_base = seq < 4 ? seq * 8192 : MPR + (seq - 4) * 4096, NC = cend;
    bf16_t* Hout = (bf16_t*)(outb + (dir ? OUT_HB : OUT_HF));
    LAS float* NV = (LAS float*)(lds + ML_NV); LAS float* QN = (LAS float*)(lds + ML_QN); LAS float* ROWS = (LAS float*)(lds + ML_ROWS);
    if (tid < 128) NV[tid] = 0.f;
    f32x4 Cacc[8];
#pragma unroll
    for (int k = 0; k < 8; ++k) Cacc[k] = (f32x4){0.f, 0.f, 0.f, 0.f};
    float m_prev = 0.f;
    const int lt = tid >> 3, dg = tid & 7;
    const int gidx_i = (dir * 2) * 4 + head, gidx_f = (dir * 2 + 1) * 4 + head;
    u32x4 rq[2], rk[2], rv[2]; float ig_n, fg_n;
    const int tokl = dir ? 63 - lane : lane;
    LAS f32x4* TOKS = (LAS f32x4*)(lds + ML_TOK);
#define ML_LOAD(cidx) do { const int c0_ = dir ? (S - 64 * ((cidx) + 1)) : 64 * (cidx); const size_t tk_ = (size_t)(tok_base + c0_ + lane); \
        const bf16_t* qp_ = QK2 + tk_ * 1024 + head * 128 + 16 * wave; const bf16_t* vp_ = QKVO + tk_ * 2048 + 1024 + head * 128 + 16 * wave; \
        rq[0] = *(const u32x4*)qp_; rq[1] = *(const u32x4*)(qp_ + 8); rk[0] = *(const u32x4*)(qp_ + 512); rk[1] = *(const u32x4*)(qp_ + 520); rv[0] = *(const u32x4*)vp_; rv[1] = *(const u32x4*)(vp_ + 8); \
        const float* gp_ = GATES + (size_t)(tok_base + c0_ + tokl) * 16; ig_n = gp_[gidx_i]; fg_n = gp_[gidx_f]; } while (0)
    ML_LOAD(0);
    LBAR();
    for (int c = 0; c < NC; ++c) {
        const int c0 = dir ? (S - 64 * (c + 1)) : 64 * c;
        const float ig = ig_n, fg = fg_n;
        const float lf = fminf(fg, 0.f) - __logf(1.f + __expf(-fabsf(fg)));
        const float bs = scan_add64(lf);
        const float uu = ig - bs;
        const float cu = scan_max64(uu);
        const float Mv = fmaxf(m_prev, cu);
        const float b_last = __builtin_bit_cast(float, __builtin_amdgcn_readlane(__builtin_bit_cast(int, bs), 63)), M_last = __builtin_bit_cast(float, __builtin_amdgcn_readlane(__builtin_bit_cast(int, Mv), 63));
        const float w_scan = __expf(uu - M_last), s_old = __expf(m_prev - M_last);
        if (wave == 0) { f32x4 tk; tk.x = __expf(m_prev - Mv); tk.y = __expf(fminf(-bs - Mv, 80.f)); tk.z = __expf(fminf(M_last - Mv, 60.f)); tk.w = 0.f; TOKS[tokl] = tk; }
        const float w_tok = dir ? xshfl(w_scan, 63 - lane) : w_scan;
        {
            LAS unsigned char* qrow = lds + ML_QS + lane * 272 + 32 * wave; LAS unsigned char* krow = lds + ML_KS + lane * 272 + 32 * wave;
            *(LAS u32x4*)qrow = rq[0]; *(LAS u32x4*)(qrow + 16) = rq[1];
            u32x4 kws[2];
#pragma unroll
            for (int h = 0; h < 2; ++h)
#pragma unroll
                for (int e = 0; e < 4; ++e) {
                    const int d = 16 * wave + 8 * h + 2 * e;
                    const unsigned kw = pk2(bflo(rk[h][e]) * w_tok, bfhi(rk[h][e]) * w_tok); kws[h][e] = kw;
                    *(LAS bf16_t*)(lds + ML_KWT + d * 144 + lane * 2) = (bf16_t)(kw & 0xffffu);
                    *(LAS bf16_t*)(lds + ML_KWT + (d + 1) * 144 + lane * 2) = (bf16_t)(kw >> 16);
                    *(LAS bf16_t*)(lds + ML_VT + d * 144 + lane * 2) = (bf16_t)(rv[h][e] & 0xffffu);
                    *(LAS bf16_t*)(lds + ML_VT + (d + 1) * 144 + lane * 2) = (bf16_t)(rv[h][e] >> 16);
                }
            *(LAS u32x4*)krow = kws[0]; *(LAS u32x4*)(krow + 16) = kws[1];
        }
        LBAR();
        if (c + 1 < NC) ML_LOAD(c + 1);
        const bool full = (c >= cfull);
        if (full) {
            const int rt = wave >> 1, ct0 = 2 * (wave & 1);
            f32x4 sacc[2] = {(f32x4){0.f, 0.f, 0.f, 0.f}, (f32x4){0.f, 0.f, 0.f, 0.f}};
#pragma unroll
            for (int ks = 0; ks < 4; ++ks) {
                const bf16x8 qf = *(const LAS bf16x8*)(lds + ML_QS + (16 * rt + fr) * 272 + (32 * ks + 8 * fq) * 2);
#pragma unroll
                for (int cc = 0; cc < 2; ++cc) { const bf16x8 kf = *(const LAS bf16x8*)(lds + ML_KS + (16 * (ct0 + cc) + fr) * 272 + (32 * ks + 8 * fq) * 2); sacc[cc] = __builtin_amdgcn_mfma_f32_16x16x32_bf16(kf, qf, sacc[cc], 0, 0, 0); }
            }
            const int t = 16 * rt + fr;
            const float rT = TOKS[t].z;
            float rs = 0.f;
#pragma unroll
            for (int cc = 0; cc < 2; ++cc) {
                float sv[4];
#pragma unroll
                for (int j = 0; j < 4; ++j) { const int s = 16 * (ct0 + cc) + 4 * fq + j; const bool keep = dir ? (s >= t) : (s <= t); const float v = keep ? sacc[cc][j] * rT : 0.f; sv[j] = v; rs += v; }
                u32x2 w; w.x = pk2(sv[0], sv[1]); w.y = pk2(sv[2], sv[3]);
                *(LAS u32x2*)(lds + ML_SM + t * 144 + (16 * (ct0 + cc) + 4 * fq) * 2) = w;
            }
            rs += xshfl_xor(rs, 16); rs += xshfl_xor(rs, 32);
            if (fq == 0) ROWS[t * 2 + (wave & 1)] = rs;
            float qd = 0.f;
            const u32x4 q0 = *(const LAS u32x4*)(lds + ML_QS + lt * 272 + 32 * dg), q1 = *(const LAS u32x4*)(lds + ML_QS + lt * 272 + 32 * dg + 16);
#pragma unroll
            for (int e = 0; e < 4; ++e) { qd += bflo(q0[e]) * NV[16 * dg + 2 * e] + bfhi(q0[e]) * NV[16 * dg + 2 * e + 1]; qd += bflo(q1[e]) * NV[16 * dg + 8 + 2 * e] + bfhi(q1[e]) * NV[16 * dg + 8 + 2 * e + 1]; }
            qd += DPPF(0.f, qd, 0x101, 0xf); qd += DPPF(0.f, qd, 0x102, 0xf); qd += DPPF(0.f, qd, 0x104, 0xf);
            if (dg == 0) QN[lt] = qd;
        }
        if (full) LBAR();
        {
            bf16x8 vf[2];
#pragma unroll
            for (int ks = 0; ks < 2; ++ks) vf[ks] = *(const LAS bf16x8*)(lds + ML_VT + (16 * wave + fr) * 144 + (32 * ks + 8 * fq) * 2);
            if (full) {
            bf16x8 cf[4];
#pragma unroll
            for (int ks = 0; ks < 4; ++ks) {
                u32x4 w; w.x = pk2(Cacc[2 * ks][0], Cacc[2 * ks][1]); w.y = pk2(Cacc[2 * ks][2], Cacc[2 * ks][3]); w.z = pk2(Cacc[2 * ks + 1][0], Cacc[2 * ks + 1][1]); w.w = pk2(Cacc[2 * ks + 1][2], Cacc[2 * ks + 1][3]);
                cf[ks] = __builtin_bit_cast(bf16x8, w);
            }
#pragma unroll
            for (int rt = 0; rt < 4; ++rt) {
                f32x4 o2 = (f32x4){0.f, 0.f, 0.f, 0.f}, o1 = (f32x4){0.f, 0.f, 0.f, 0.f};
#pragma unroll
                for (int ks = 0; ks < 2; ++ks) { const bf16x8 sf = *(const LAS bf16x8*)(lds + ML_SM + (16 * rt + fr) * 144 + (32 * ks + 8 * fq) * 2); o2 = __builtin_amdgcn_mfma_f32_16x16x32_bf16(vf[ks], sf, o2, 0, 0, 0); }
#pragma unroll
                for (int ks = 0; ks < 4; ++ks) {
                    const u32x2 qlo = *(const LAS u32x2*)(lds + ML_QS + (16 * rt + fr) * 272 + (32 * ks + 4 * fq) * 2), qhi = *(const LAS u32x2*)(lds + ML_QS + (16 * rt + fr) * 272 + (32 * ks + 16 + 4 * fq) * 2);
                    u32x4 w; w.x = qlo.x; w.y = qlo.y; w.z = qhi.x; w.w = qhi.y;
                    o1 = __builtin_amdgcn_mfma_f32_16x16x32_bf16(cf[ks], __builtin_bit_cast(bf16x8, w), o1, 0, 0, 0);
                }
                const int t = 16 * rt + fr;
                const f32x4 tk = TOKS[t]; const float it = tk.x, el = tk.y;
                const float den = it * QN[t] + ROWS[2 * t] + ROWS[2 * t + 1];
                const float r = __builtin_amdgcn_rcpf(fmaxf(fabsf(den), el));
                u32x2 w; w.x = pk2((it * o1[0] + o2[0]) * r, (it * o1[1] + o2[1]) * r); w.y = pk2((it * o1[2] + o2[2]) * r, (it * o1[3] + o2[3]) * r);
                *(u32x2*)(Hout + (size_t)(tok_base + c0 + t) * 512 + head * 128 + 16 * wave + 4 * fq) = w;
            }
            }
#pragma unroll
            for (int kt = 0; kt < 8; ++kt) {
                Cacc[kt] = Cacc[kt] * s_old;
#pragma unroll
                for (int ks = 0; ks < 2; ++ks) { const bf16x8 kwf = *(const LAS bf16x8*)(lds + ML_KWT + (16 * kt + fr) * 144 + (32 * ks + 8 * fq) * 2); Cacc[kt] = __builtin_amdgcn_mfma_f32_16x16x32_bf16(kwf, vf[ks], Cacc[kt], 0, 0, 0); }
                if (kt & 1) asm volatile("" ::: "memory");
            }
            const int d = tid >> 2, part = tid & 3;
            const u32x4 k0 = *(const LAS u32x4*)(lds + ML_KWT + d * 144 + part * 32), k1 = *(const LAS u32x4*)(lds + ML_KWT + d * 144 + part * 32 + 16);
            float sm = 0.f;
#pragma unroll
            for (int e = 0; e < 4; ++e) sm += bflo(k0[e]) + bfhi(k0[e]) + bflo(k1[e]) + bfhi(k1[e]);
            sm += DPPF(0.f, sm, 0x101, 0xf); sm += DPPF(0.f, sm, 0x102, 0xf);
            if (part == 0) NV[d] = s_old * NV[d] + sm;
        }
        m_prev = b_last + M_last;
        LBAR();
    }
#undef ML_LOAD
}

#define XB_TMO      128
#define XB_XCNT(j)  (256  + 64 * (j))
#define XB_XSUB(j)  (1280 + 64 * (j))
#define XB_XGEN(j)  (2304 + 64 * (j))
#define XB_TOP      3328
#define XB_TOPGEN   3392
#define XCD_BAR_WORDS 3456
#define XB_SPIN_CAP (1u << 22)
__device__ __forceinline__ unsigned xb_ld(unsigned* p)              { return __hip_atomic_load(p, __ATOMIC_RELAXED, __HIP_MEMORY_SCOPE_AGENT); }
__device__ __forceinline__ unsigned xb_add(unsigned* p, unsigned v) { return __hip_atomic_fetch_add(p, v, __ATOMIC_RELAXED, __HIP_MEMORY_SCOPE_AGENT); }
__device__ __forceinline__ unsigned xb_xcc_id() { return (unsigned)__builtin_amdgcn_s_getreg((3 << 11) | 20) & 0xFu; }
#define XB_SPIN(cond, bar) do { unsigned _sp = 0; while (cond) { __builtin_amdgcn_s_sleep(1); \
    if ((++_sp & 255u) == 0u) { if (xb_ld(&(bar)[XB_TMO])) break; if (_sp > XB_SPIN_CAP) { atomicAdd(&(bar)[XB_TMO], 1u); break; } } } } while (0)
struct XcdBarrier { unsigned* bar; unsigned x; volatile LAS unsigned* st; };
__device__ __forceinline__ XcdBarrier xcd_barrier_post(unsigned* bar, volatile LAS unsigned* st) {
    XcdBarrier b; b.bar = bar; b.x = xb_xcc_id(); b.st = st;
    if (opaque_tid() == 0) (void)xb_add(&bar[XB_XCNT(b.x)], 1u);
    return b;
}
__device__ __forceinline__ void xcd_barrier_complete(unsigned* bar, unsigned x, unsigned& nloc, unsigned& nx) {
    const unsigned G = gridDim.x * gridDim.y * gridDim.z;
    unsigned sum, cnt, mine, sp = 0u;
    for (;;) {
        sum = 0u; cnt = 0u; mine = 0u;
#pragma unroll
        for (unsigned j = 0; j < 16; ++j) { const unsigned c = xb_ld(&bar[XB_XCNT(j)]); sum += c; cnt += (c > 0u) ? 1u : 0u; mine = (j == x) ? c : mine; }
        if (sum == G) break;
        __builtin_amdgcn_s_sleep(1);
        if ((++sp & 255u) == 0u) { if (xb_ld(&bar[XB_TMO])) break; if (sp > XB_SPIN_CAP) { atomicAdd(&bar[XB_TMO], 1u); break; } }
    }
    nloc = mine > 0u ? mine : 1u; nx = cnt > 0u ? cnt : 1u;
}
__device__ __forceinline__ void xcd_barrier(const XcdBarrier& b) {
    asm volatile("s_waitcnt vmcnt(0)" ::: "memory");
    __syncthreads();
    if (opaque_tid() == 0) {
        unsigned* bar = b.bar;
        __builtin_amdgcn_s_waitcnt(0);
        unsigned nloc = b.st[0], nx = b.st[1];
        if (nloc == 0u) { xcd_barrier_complete(bar, b.x, nloc, nx); b.st[0] = nloc; b.st[1] = nx; }
        const unsigned old = xb_add(&bar[XB_XSUB(b.x)], 1u);
        const unsigned gen = old / nloc;
        if (old + 1u == (gen + 1u) * nloc) {
            __builtin_amdgcn_fence(__ATOMIC_RELEASE, "agent");
            asm volatile("s_waitcnt vmcnt(0)" ::: "memory");
            const unsigned og = xb_add(&bar[XB_TOP], 1u);
            const unsigned tg = og / nx;
            if (og + 1u == (tg + 1u) * nx) xb_add(&bar[XB_TOPGEN], 1u);
            else XB_SPIN(xb_ld(&bar[XB_TOPGEN]) == tg, bar);
            __builtin_amdgcn_fence(__ATOMIC_ACQUIRE, "agent");
            xb_add(&bar[XB_XGEN(b.x)], 1u);
            asm volatile("s_waitcnt vmcnt(0)" ::: "memory");
        } else {
            XB_SPIN(xb_ld(&bar[XB_XGEN(b.x)]) == gen, bar);
            __builtin_amdgcn_fence(__ATOMIC_ACQUIRE, "agent");
            asm volatile("s_waitcnt vmcnt(0)" ::: "memory");
        }
    }
    __syncthreads();
}

struct Args { const float* in[23]; float* out; unsigned char* ws; };

__device__ __forceinline__ void transpose_item(const float* W, int pitch, int K, bf16_t* WT, int n0, int dst_row0, int k0, LAS float* scr, int lane) {
#pragma unroll 8
    for (int i = 0; i < 32; ++i) { const int kk = 2 * i + (lane >> 5); scr[kk * 33 + (lane & 31)] = W[(size_t)(k0 + kk) * pitch + n0 + (lane & 31)]; }
    LDS_WAIT(); asm volatile("" ::: "memory");
    const int c = lane & 7;
#pragma unroll
    for (int j = 0; j < 4; ++j) { const int n = (lane >> 3) + 8 * j; const LAS float* s = scr + (8 * c) * 33 + n;
        u32x4 o; o.x = pk2(s[0 * 33], s[1 * 33]); o.y = pk2(s[2 * 33], s[3 * 33]); o.z = pk2(s[4 * 33], s[5 * 33]); o.w = pk2(s[6 * 33], s[7 * 33]);
        *(u32x4*)(WT + (size_t)(dst_row0 + n) * K + k0 + 8 * c) = o; }
    LDS_WAIT(); asm volatile("" ::: "memory");
}

__global__ void __launch_bounds__(512, 2) fwd_kernel(Args a) {
    extern __shared__ __attribute__((aligned(16))) unsigned char lds_raw[];
    LAS unsigned char* lds = (LAS unsigned char*)lds_raw;
    cg::grid_group grid = cg::this_grid();
#define PHASE_IDS const int tid = opaque_tid(), lane = tid & 63, wave = __builtin_amdgcn_readfirstlane(tid >> 6); const int gw = blockIdx.x * 8 + wave, NGW = G * 8; (void)lane; (void)gw; (void)NGW; (void)tid
    const int G = gridDim.x;
    LAS unsigned* bst = (LAS unsigned*)(lds + LDS_BYTES - 32);
    if (opaque_tid() == 0) { bst[0] = 0u; bst[1] = 0u; }
    __syncthreads();
    const XcdBarrier xbar = xcd_barrier_post((unsigned*)(a.ws + WS_BAR), (volatile LAS unsigned*)bst);
#define GSYNC() xcd_barrier(xbar)
    unsigned char* ws = a.ws; unsigned char* outb = (unsigned char*)a.out;
    unsigned* ctl = (unsigned*)(ws + WS_CTL);
    bf16_t* W1T = (bf16_t*)(ws + WS_W1T); bf16_t* W2T = (bf16_t*)(ws + WS_W2T); bf16_t* W3T = (bf16_t*)(ws + WS_W3T); bf16_t* W4T = (bf16_t*)(ws + WS_W4T);
    float* HID = (float*)(ws + WS_HID); float* GATES = (float*)(ws + WS_GATES);
    bf16_t* R1 = (bf16_t*)(ws + WS_R1) + R1_PAD_ROWS * 1024;
    bf16_t* YH = (bf16_t*)(ws + WS_YH); bf16_t* HX = (bf16_t*)(ws + WS_HX); bf16_t* QKVO = (bf16_t*)(ws + WS_QKVO); bf16_t* ACT = (bf16_t*)(ws + WS_ACT);
    const float* xp = a.in[0]; const float* xs = a.in[1];
    bf16_t* H2U = (bf16_t*)(ws + WS_H2U); float* SS = (float*)(ws + WS_SS);

    {
        PHASE_IDS;
        if (blockIdx.x == 0 && tid == 0) { ctl[0] = 0u; }
        for (int i = blockIdx.x * 512 + tid - 1; i < MTOK + 512; i += G * 512) SS[i] = 0.f;
#ifdef REP_P0
        for (int rep_ = 0; rep_ < 2; ++rep_) {
#endif
        LAS float* scr = (LAS float*)(lds + wave * 8448);
        constexpr int I1 = 16 * 112, I2 = 16 * 32, I3 = 16 * 176, I4 = 44 * 32;
        for (int it = gw; it < I1 + I2 + I3 + I4; it += NGW) {
            int r = it;
            if (r < I1) { const int kb = r / 112, nb = r % 112; transpose_item(a.in[3], PIN, 1024, W1T, 32 * nb, 32 * nb, 64 * kb, scr, lane); continue; } r -= I1;
            if (r < I2) { const int kb = r / 32, nb = r % 32; transpose_item(a.in[16], 1024, 1024, W2T, 32 * nb, 32 * nb, 64 * kb, scr, lane); continue; } r -= I2;
            if (r < I3) { const int kb = r / 176, nb = r % 176; const int n0 = 32 * nb; const int gate = n0 >= FF, cc = gate ? n0 - FF : n0; const int drow = (cc >> 7) * 256 + gate * 128 + (cc & 127);
                transpose_item(a.in[18], FF2, 1024, W3T, n0, drow, 64 * kb, scr, lane); continue; } r -= I3;
            { const int kb = r / 32, nb = r % 32; transpose_item(a.in[21], 1024, FF, W4T, 32 * nb, 32 * nb, 64 * kb, scr, lane); }
        }
        __syncthreads();
        LAS float* GWl = (LAS float*)(lds + 69632);
        for (int i = tid; i < 16 * 1024; i += 512) { const int k = i >> 4, gt = i & 15; GWl[gt * 1024 + k] = a.in[3][(size_t)k * PIN + NP1 + gt]; }
        __syncthreads();
        f32x4 g1[4];
#pragma unroll
        for (int j = 0; j < 4; ++j) g1[j] = ((const f32x4*)a.in[2])[lane + 64 * j];
        f32x4 nx[2][4];
#define P0_LOAD(mm) do { _Pragma("unroll") for (int r_ = 0; r_ < 2; ++r_) { const int mr_ = (mm) + r_; const float* xrow_ = mr_ < MPR ? xp + (size_t)mr_ * DM : xs + (size_t)(mr_ - MPR) * DM; \
            _Pragma("unroll") for (int j_ = 0; j_ < 4; ++j_) nx[r_][j_] = ((const f32x4*)xrow_)[lane + 64 * j_]; } } while (0)
        if (2 * gw < MTOK) P0_LOAD(2 * gw);
        for (int m = 2 * gw; m < MTOK; m += 2 * NGW) {
            f32x4 v[2][4];
#pragma unroll
            for (int r = 0; r < 2; ++r)
#pragma unroll
                for (int j = 0; j < 4; ++j) v[r][j] = nx[r][j];
            if (m + 2 * NGW < MTOK) P0_LOAD(m + 2 * NGW);
#pragma unroll
            for (int r = 0; r < 2; ++r) {
                const int mr = m + r;
                float s = 0.f;
#pragma unroll
                for (int j = 0; j < 4; ++j) s += (v[r][j].x * v[r][j].x + v[r][j].y * v[r][j].y) + (v[r][j].z * v[r][j].z + v[r][j].w * v[r][j].w);
                const float rs = rsqrtf(wave_sum(s) * (1.f / DM) + 1e-6f);
                unsigned long long* o8 = (unsigned long long*)(R1 + (size_t)mr * DM) + lane;
#pragma unroll
                for (int j = 0; j < 4; ++j) { v[r][j] = v[r][j] * rs * g1[j]; o8[64 * j] = (unsigned long long)pk2(v[r][j].x, v[r][j].y) | ((unsigned long long)pk2(v[r][j].z, v[r][j].w) << 32); }
            }
            float p[32];
#pragma unroll
            for (int gt = 0; gt < 16; ++gt) {
                float p0 = 0.f, p1 = 0.f;
#pragma unroll
                for (int j = 0; j < 4; ++j) { const f32x4 w = *(const LAS f32x4*)(GWl + gt * 1024 + 256 * j + 4 * lane);
                    p0 += (v[0][j].x * w.x + v[0][j].y * w.y) + (v[0][j].z * w.z + v[0][j].w * w.w); p1 += (v[1][j].x * w.x + v[1][j].y * w.y) + (v[1][j].z * w.z + v[1][j].w * w.w); }
                p[gt] = p0; p[16 + gt] = p1;
                if ((gt & 3) == 3) asm volatile("" ::: "memory");
            }
            { const bool hi = (lane & 32) != 0;
#pragma unroll
              for (int g = 0; g < 16; ++g) { const float mine = hi ? p[16 + g] : p[g], oth = hi ? p[g] : p[16 + g]; p[g] = mine + xshfl_xor(oth, 32); } }
            { const bool hi = (lane & 16) != 0;
#pragma unroll
              for (int g = 0; g < 8; ++g) { const float mine = hi ? p[8 + g] : p[g], oth = hi ? p[g] : p[8 + g]; p[g] = mine + xshfl_xor(oth, 16); } }
            { const bool hi = (lane & 8) != 0;
#pragma unroll
              for (int g = 0; g < 4; ++g) { const float mine = hi ? p[4 + g] : p[g], oth = hi ? p[g] : p[4 + g]; p[g] = mine + xshfl_xor(oth, 8); } }
            { const bool hi = (lane & 4) != 0;
#pragma unroll
              for (int g = 0; g < 2; ++g) { const float mine = hi ? p[2 + g] : p[g], oth = hi ? p[g] : p[2 + g]; p[g] = mine + xshfl_xor(oth, 4); } }
            { const bool hi = (lane & 2) != 0; const float mine = hi ? p[1] : p[0], oth = hi ? p[0] : p[1]; p[0] = mine + xshfl_xor(oth, 2); }
            p[0] += xshfl_xor(p[0], 1);
            const int gate = ((lane >> 4) & 1) * 8 + ((lane >> 3) & 1) * 4 + ((lane >> 2) & 1) * 2 + ((lane >> 1) & 1);
            if ((lane & 1) == 0) GATES[(size_t)(m + (lane >> 5)) * 16 + gate] = p[0] + a.in[6][gate];
        }
        for (int pos = gw; pos < 12288; pos += NGW) {
            const int L = pos < 8192 ? 8192 : 4096, t = pos < 8192 ? pos : pos - 8192;
            float z = 0.f;
            if (lane == 0) z = (float)t / (float)(L - 1);
            else if (lane <= 32) { const int jb = (lane - 1) & 15; const double frq = 1e-4 + (double)jb * ((15.0 - 1e-4) / 15.0); double r = (double)t * frq / (double)L; r -= floor(r); const float rf = (float)r;
                z = lane <= 16 ? __builtin_amdgcn_cosf(rf) : -__builtin_amdgcn_sinf(rf); }
            float a1 = a.in[8][lane];
            for (int e = 0; e < 33; ++e) a1 += xshfl(z, e) * a.in[7][e * 64 + lane];
            const float h1 = sin_rad(a.in[9][lane] * a1);
            float a2 = a.in[11][lane];
            for (int j = 0; j < 64; ++j) a2 += xshfl(h1, j) * a.in[10][j * 64 + lane];
            HID[(size_t)pos * 64 + lane] = sin_rad(a.in[12][lane] * a2);
        }
#ifdef REP_P0
        __syncthreads(); }
#endif
    }
    grid.sync();

    {
        PHASE_IDS;
        pg8::Gemm g{R1, W1T, 1024, 256, 0, 4, 1, 128};
        pg8::StaticOrder S; S.init(MTOK / 256, NP1 / 256, G, (int)blockIdx.x);
        pg8::EpiG1 E{HX, QKVO};
#ifdef REP_G1
        pg8::gemm_phase<pg8::EpiG1, pg8::StaticOrder, true, true>(lds, g, S, E); GSYNC();
#endif
        pg8::gemm_phase<pg8::EpiG1, pg8::StaticOrder, true, true>(lds, g, S, E);
        __syncthreads();
        for (int it = blockIdx.x; it < 768; it += G) taps_item(lds, it, HID, a.in[13], outb);
    }
    GSYNC();

    {
        PHASE_IDS;
        float cw0[16], cw1[16], cw2[16], cbb[16];
#pragma unroll
        for (int e = 0; e < 16; ++e) { const int col = 1536 + 16 * lane + e; cw0[e] = a.in[4][col]; cw1[e] = a.in[4][2560 + col]; cw2[e] = a.in[4][2 * 2560 + col]; cbb[e] = a.in[5][col]; }
        const float ksc = lane >= 32 ? 0.08838834764831845f : 1.0f;
        constexpr int RUN = 48;
        for (int t0 = gw * RUN; t0 < MTOK; t0 += NGW * RUN) {
            u32x4 pv[2], cv[2], nv[2], n2[2], n3[2];
#define P1B_ROW(dst_, r_) do { const int rr_ = (r_) < 0 ? 0 : ((r_) < MTOK ? (r_) : MTOK - 1); const bf16_t* p_ = QKVO + (size_t)rr_ * 2048 + 16 * lane; dst_[0] = *(const u32x4*)p_; dst_[1] = *(const u32x4*)(p_ + 8); } while (0)
            P1B_ROW(pv, t0 - 1); P1B_ROW(cv, t0); P1B_ROW(nv, t0 + 1); P1B_ROW(n2, t0 + 2); P1B_ROW(n3, t0 + 3);
            for (int i = 0; i < RUN; ++i) {
                const int t = t0 + i;
                u32x4 n4[2]; P1B_ROW(n4, t + 4);
                const float mp = pg8::seq_start(t) ? 0.f : 1.f, mn = pg8::seq_start(t + 1) ? 0.f : 1.f;
                u32x4 o[2];
#pragma unroll
                for (int h = 0; h < 2; ++h)
#pragma unroll
                    for (int e = 0; e < 4; ++e) {
                        const int d0 = 8 * h + 2 * e;
                        const float c0 = mp * cw0[d0] * bflo(pv[h][e]) + cw1[d0] * bflo(cv[h][e]) + mn * cw2[d0] * bflo(nv[h][e]) + cbb[d0];
                        const float c1 = mp * cw0[d0 + 1] * bfhi(pv[h][e]) + cw1[d0 + 1] * bfhi(cv[h][e]) + mn * cw2[d0 + 1] * bfhi(nv[h][e]) + cbb[d0 + 1];
                        o[h][e] = pk2(c0 * fsigmoid(c0) * ksc, c1 * fsigmoid(c1) * ksc);
                    }
                bf16_t* dst = R1 + (size_t)t * 1024 + 16 * lane;
                *(u32x4*)dst = o[0]; *(u32x4*)(dst + 8) = o[1];
                pv[0] = cv[0]; pv[1] = cv[1]; cv[0] = nv[0]; cv[1] = nv[1]; nv[0] = n2[0]; nv[1] = n2[1]; n2[0] = n3[0]; n2[1] = n3[1]; n3[0] = n4[0]; n3[1] = n4[1];
            }
#undef P1B_ROW
        }
    }
    { __syncthreads(); for (int it = blockIdx.x; it < 2048; it += G) spectrum_item(lds, it, a.in[14], outb); }
    GSYNC();

#if defined(EXP_MLSTM)
    { for (int it = blockIdx.x; it < 192; it += G) { __syncthreads(); mlstm_item(lds, it, QKVO, R1, GATES, outb); } }
    GSYNC();
#endif
#if defined(EXP_HYENA)
    { for (int it = blockIdx.x; it < HY_ITEMS; it += G) { __syncthreads(); hyena_item(lds, it, HX, YH, a.in[4], a.in[5], outb); } }
    GSYNC();
#endif
    {
        PHASE_IDS;
        LAS int* slot = (LAS int*)(lds + LDS_BYTES - 16);
        for (;;) {
            LBAR();
            if (tid == 0) *slot = (int)atomicAdd(ctl, 1u);
            LBAR();
            const int item = *slot;
            if (item >= 192 + HY_ITEMS) break;
            if (item < 192) mlstm_item(lds, item, QKVO, R1, GATES, outb);
            else hyena_item(lds, item - 192, HX, YH, a.in[4], a.in[5], outb);
        }
    }
    GSYNC();

#ifdef REP_P2
    if (blockIdx.x == 0 && opaque_tid() == 0) ((unsigned*)(ws + WS_CTL))[0] = 0u;
    GSYNC();
    {
        const int tid = opaque_tid();
        LAS int* slot = (LAS int*)(lds + LDS_BYTES - 16);
        for (;;) {
            __syncthreads();
            if (tid == 0) *slot = (int)atomicAdd((unsigned*)(ws + WS_CTL), 1u);
            __syncthreads();
            const int item = *slot;
            if (item >= 192 + HY_ITEMS) break;
            if (item < 192) mlstm_item(lds, item, QKVO, R1, GATES, outb);
            else hyena_item(lds, item - 192, HX, YH, a.in[4], a.in[5], outb);
        }
    }
    GSYNC();
#endif
#ifdef REP_SYNC
    for (int i_ = 0; i_ < 10; ++i_) GSYNC();
#endif
    {
        PHASE_IDS;
        const bf16_t* YV = YH;
        const bf16_t* HF = (const bf16_t*)(outb + OUT_HF); const bf16_t* HB = (const bf16_t*)(outb + OUT_HB);
        LAS bf16_t* tl = (LAS bf16_t*)lds;
        u32x4 n0 = (u32x4){0u, 0u, 0u, 0u}, n1 = n0;
#define P2C_SRC(it_) ({ const int tt_ = (it_) >> 3, cb_ = (it_) & 7, tok_ = tt_ * 128; size_t sb_; int S_, s0_; \
            if (tok_ < MPR) { S_ = 8192; s0_ = tok_ & 8191; sb_ = (size_t)(tok_ >> 13) * 512 * 8192; } else { S_ = 4096; const int t2_ = tok_ - MPR; s0_ = t2_ & 4095; sb_ = (size_t)MPR * 512 + (size_t)(t2_ >> 12) * 512 * 4096; } \
            YV + sb_ + (size_t)(cb_ * 64 + (tid >> 3)) * S_ + s0_ + 16 * (tid & 7); })
        if ((int)blockIdx.x < 768 * 8) { const bf16_t* sp = P2C_SRC((int)blockIdx.x); n0 = *(const u32x4*)sp; n1 = *(const u32x4*)(sp + 8); }
        for (int it = blockIdx.x; it < 768 * 8; it += G) {
            const int tt = it >> 3, cb = it & 7, tok0 = tt * 128;
            const u32x4 r0 = n0, r1 = n1;
            if (it + G < 768 * 8) { const bf16_t* sp = P2C_SRC(it + G); n0 = *(const u32x4*)sp; n1 = *(const u32x4*)(sp + 8); }
            LBAR();
            { const int chl = tid >> 3, seg = tid & 7;
              *(LAS u32x4*)(tl + chl * 136 + 16 * seg) = r0; *(LAS u32x4*)(tl + chl * 136 + 16 * seg + 8) = r1; }
            LBAR();
            { const int tk = tid >> 2, cgp = tid & 3; unsigned w[8];
#pragma unroll
              for (int e = 0; e < 8; ++e) { const unsigned lo = tl[(16 * cgp + 2 * e) * 136 + tk], hi = tl[(16 * cgp + 2 * e + 1) * 136 + tk]; w[e] = lo | (hi << 16); }
              bf16_t* dst = R1 + (size_t)(tok0 + tk) * DM + cb * 64 + 16 * cgp;
              u32x4 o0, o1; o0.x = w[0]; o0.y = w[1]; o0.z = w[2]; o0.w = w[3]; o1.x = w[4]; o1.y = w[5]; o1.z = w[6]; o1.w = w[7];
              *(u32x4*)dst = o0; *(u32x4*)(dst + 8) = o1; }
        }
#undef P2C_SRC
        f32x4 mg0 = ((const f32x4*)a.in[15])[2 * lane], mg1 = ((const f32x4*)a.in[15])[2 * lane + 1];
        u32x4 nf, nb, no;
        if (gw < MTOK) { nf = *(const u32x4*)(HF + (size_t)gw * 512 + 8 * lane); nb = *(const u32x4*)(HB + (size_t)gw * 512 + 8 * lane); no = *(const u32x4*)(QKVO + (size_t)gw * 2048 + 1536 + 8 * lane); }
        for (int m = gw; m < MTOK; m += NGW) {
            const u32x4 f = nf, b = nb, o = no;
            if (m + NGW < MTOK) { const size_t m2 = (size_t)(m + NGW); nf = *(const u32x4*)(HF + m2 * 512 + 8 * lane); nb = *(const u32x4*)(HB + m2 * 512 + 8 * lane); no = *(const u32x4*)(QKVO + m2 * 2048 + 1536 + 8 * lane); }
            float h[8]; float ss = 0.f;
#pragma unroll
            for (int e = 0; e < 4; ++e) { h[2 * e] = bflo(f[e]) + bflo(b[e]); h[2 * e + 1] = bfhi(f[e]) + bfhi(b[e]); ss += h[2 * e] * h[2 * e] + h[2 * e + 1] * h[2 * e + 1]; }
            ss += xshfl_xor(ss, 1); ss += xshfl_xor(ss, 2); ss += xshfl_xor(ss, 4); ss += xshfl_xor(ss, 8);
            const float rs = rsqrtf(ss * (1.f / 128.f) + 1e-6f);
            float y[8];
#pragma unroll
            for (int e = 0; e < 4; ++e) { y[2 * e] = h[2 * e] * rs * (e < 2 ? mg0[2 * e] : mg1[2 * e - 4]) * bflo(o[e]); y[2 * e + 1] = h[2 * e + 1] * rs * (e < 2 ? mg0[2 * e + 1] : mg1[2 * e - 3]) * bfhi(o[e]); }
            u32x4 w; w.x = pk2(y[0], y[1]); w.y = pk2(y[2], y[3]); w.z = pk2(y[4], y[5]); w.w = pk2(y[6], y[7]);
            *(u32x4*)(R1 + (size_t)m * DM + 512 + 8 * lane) = w;
        }
    }
    GSYNC();

    {
        PHASE_IDS;
        pg8::Gemm g{R1, W2T, 1024, 256, 0, 128, 0, 0};
        pg8::StaticOrder S; S.init(MTOK / 256, 4, G, (int)blockIdx.x);
        pg8::EpiG2 E{xp, xs, a.out, a.in[17], H2U, SS};
#ifdef REP_G2
        pg8::gemm_phase<pg8::EpiG2, pg8::StaticOrder, true, true>(lds, g, S, E); GSYNC();
#endif
        pg8::gemm_phase<pg8::EpiG2, pg8::StaticOrder, true, true>(lds, g, S, E);
    }
    GSYNC();

    {
        PHASE_IDS;
        pg8::Gemm g{H2U, W3T, 1024, 252, -1, 4, 1, 126};
        pg8::StaticOrder S; S.init(391, 22, G, (int)blockIdx.x);
        pg8::EpiG3 E{a.in[19], a.in[20], ACT, SS};
#ifdef REP_G3
        pg8::gemm_phase<pg8::EpiG3, pg8::StaticOrder, true, true>(lds, g, S, E); GSYNC();
#endif
        pg8::gemm_phase<pg8::EpiG3, pg8::StaticOrder, true, true>(lds, g, S, E);
    }
    GSYNC();

    {
        PHASE_IDS;
        pg8::Gemm g{ACT, W4T, FF, 256, 0, 128, 0, 0};
        pg8::StaticOrder S; S.init(MTOK / 256, 4, G, (int)blockIdx.x);
        pg8::EpiG4 E{a.out};
        pg8::gemm_phase<pg8::EpiG4, pg8::StaticOrder, true, true>(lds, g, S, E);
    }
    GSYNC();

    {
        PHASE_IDS;
        f32x4 gf[4];
#pragma unroll
        for (int j = 0; j < 4; ++j) gf[j] = ((const f32x4*)a.in[22])[lane + 64 * j];
        for (int m = gw; m < MTOK; m += NGW) {
            float* xrow = a.out + (size_t)m * DM;
            f32x4 v[4]; float s = 0.f;
#pragma unroll
            for (int j = 0; j < 4; ++j) { v[j] = ((const f32x4*)xrow)[lane + 64 * j]; s += (v[j].x * v[j].x + v[j].y * v[j].y) + (v[j].z * v[j].z + v[j].w * v[j].w); }
            const float rs = rsqrtf(wave_sum(s) * (1.f / DM) + 1e-6f);
#pragma unroll
            for (int j = 0; j < 4; ++j) ((f32x4*)xrow)[lane + 64 * j] = v[j] * rs * gf[j];
        }
    }
}

extern "C" void kernel_launch(void* const* d_in, const int* in_sizes, int n_in, void* d_out, int out_size, void* d_ws, size_t ws_size, hipStream_t stream) {
    static int grid = 0;
    if (grid == 0) {
        int dev = 0, cus = 0, per_cu = 0;
        (void)hipGetDevice(&dev);
        (void)hipDeviceGetAttribute(&cus, hipDeviceAttributeMultiprocessorCount, dev);
        (void)hipFuncSetAttribute((const void*)fwd_kernel, hipFuncAttributeMaxDynamicSharedMemorySize, LDS_BYTES);
        (void)hipOccupancyMaxActiveBlocksPerMultiprocessor(&per_cu, (const void*)fwd_kernel, 512, LDS_BYTES);
        (void)hipGetLastError();
        grid = cus > 0 ? cus : 256;
        if (n_in != 23 || ws_size < WS_END) fprintf(stderr, "kernel_launch: unexpected n_in %d / ws %zu\n", n_in, ws_size);
    }
    (void)hipMemsetAsync((char*)d_ws + WS_BAR, 0, 16384, stream);
    Args a{};
    for (int i = 0; i < 23; ++i) a.in[i] = (const float*)d_in[i];
    a.out = (float*)d_out; a.ws = (unsigned char*)d_ws;
    void* args[] = {&a};
    hipError_t e = hipLaunchCooperativeKernel((void*)fwd_kernel, dim3(grid), dim3(512), args, LDS_BYTES, stream);
    if (e != hipSuccess) fprintf(stderr, "cooperative launch failed: %s (grid %d)\n", hipGetErrorString(e), grid);
}
```
